# Optimizing an MI355X kernel written in HIP

```python
import jax, jax.numpy as jnp
from jax import lax
import numpy as np

D_MODEL = 1024
BATCH = 32
SEQ = 256
DEPTH = 2
DEC_BATCH = 4
DEC_SEQ = 2048
PAST_LEN = 256

GRID_W = 64
BLOCK = 128
WINDOW = 128
ROPE_BASE = 10000.0
NORM_EPS = 1e-6
NEG_INF = -1e30

N_BRANCH = 4
BRANCH_W = D_MODEL // N_BRANCH
HEAD_DIM = 64

MLA_HEADS = BRANCH_W // HEAD_DIM
MLA_NOPE = HEAD_DIM
MLA_ROPE = HEAD_DIM // 2
MLA_V = HEAD_DIM
MLA_Q_RANK = BRANCH_W
MLA_KV_RANK = BRANCH_W // 2
MLA_SCALE = (MLA_NOPE + MLA_ROPE) ** -0.5

RET_HEADS = BRANCH_W // HEAD_DIM
RET_DK = HEAD_DIM
RET_DV = HEAD_DIM

WIN_HEADS = BRANCH_W // HEAD_DIM
WIN_KV_HEADS = WIN_HEADS // 2
WIN_GROUP = WIN_HEADS // WIN_KV_HEADS

GQA_HEADS = BRANCH_W // HEAD_DIM
GQA_KV_HEADS = GQA_HEADS // 2
GQA_GROUP = GQA_HEADS // GQA_KV_HEADS

ATT_SCALE = HEAD_DIM ** -0.5
D_FF = 4 * D_MODEL
ALPHA = (2.0 * DEPTH) ** 0.25
BETA = (8.0 * DEPTH) ** -0.25

IN_SIZES = (MLA_Q_RANK, MLA_KV_RANK, MLA_ROPE,
            RET_HEADS * RET_DK, RET_HEADS * RET_DK, RET_HEADS * RET_DV, RET_HEADS * RET_DV,
            WIN_HEADS * HEAD_DIM, WIN_KV_HEADS * HEAD_DIM, WIN_KV_HEADS * HEAD_DIM,
            GQA_HEADS * HEAD_DIM, GQA_KV_HEADS * HEAD_DIM, GQA_KV_HEADS * HEAD_DIM,
            N_BRANCH * D_MODEL)
IN_DIM = sum(IN_SIZES)

kernel_name = 'hybrid_diffusion_parallel_mla_retention_window_qknorm'


def _rmsnorm(x, g):
    xf = x.astype(jnp.float32)
    y = xf * lax.rsqrt(jnp.mean(xf * xf, -1, keepdims=True) + NORM_EPS)
    return (y * g.astype(jnp.float32)).astype(x.dtype)


def _layernorm(x, g, b):
    xf = x.astype(jnp.float32)
    mu = jnp.mean(xf, -1, keepdims=True)
    var = jnp.mean(jnp.square(xf - mu), -1, keepdims=True)
    y = (xf - mu) * lax.rsqrt(var + NORM_EPS) * g.astype(jnp.float32) + b.astype(jnp.float32)
    return y.astype(x.dtype)


def _axial_rope(t, rot_dim):
    rows = t // GRID_W
    row = jnp.repeat(jnp.arange(rows, dtype=jnp.float32), GRID_W)
    col = (jnp.arange(t) % GRID_W).astype(jnp.float32)
    n_freq = rot_dim // 4
    inv = ROPE_BASE ** (-jnp.arange(n_freq, dtype=jnp.float32) / n_freq)
    ang = jnp.concatenate([row[:, None] * inv, col[:, None] * inv], axis=-1)
    return jnp.cos(ang), jnp.sin(ang)


def _apply_rope(x, cos, sin):
    half = x.shape[-1] // 2
    x1, x2 = x[..., :half], x[..., half:]
    c = cos[None, :, None, :].astype(x.dtype)
    s = sin[None, :, None, :].astype(x.dtype)
    return jnp.concatenate([x1 * c - x2 * s, x1 * s + x2 * c], axis=-1)


def _softmax(s, sink):
    if sink is None:
        return jax.nn.softmax(s, axis=-1)
    sink = sink.astype(jnp.float32)
    m = jnp.maximum(jnp.max(s, -1, keepdims=True), sink)
    e = jnp.exp(s - m)
    return e / (jnp.sum(e, -1, keepdims=True) + jnp.exp(sink - m))


def _dense_attention(q, k, v, sink=None):
    b, t, kh, g, dq = q.shape
    dv = v.shape[-1]
    nb = t // BLOCK
    qb = jnp.moveaxis(q.reshape(b, nb, BLOCK, kh, g, dq), 1, 0)
    sink_b = None if sink is None else sink[None, :, :, None, None]

    def one_block(qblk):
        s = jnp.einsum('bqkgd,bskd->bkgqs', qblk, k).astype(jnp.float32)
        p = _softmax(s, sink_b).astype(v.dtype)
        return jnp.einsum('bkgqs,bskd->bqkgd', p, v)

    o = lax.map(one_block, qb)
    return jnp.moveaxis(o, 0, 1).reshape(b, t, kh, g, dv)


def _banded_attention(q, k, v, k_ctx, v_ctx, sink):
    b, t, kh, g, d = q.shape
    nb = t // BLOCK
    pad = ((0, 0), (BLOCK, BLOCK), (0, 0), (0, 0))

    def band(a):
        ap = jnp.pad(a, pad).reshape(b, nb + 2, BLOCK, kh, a.shape[-1])
        return jnp.concatenate([ap[:, :-2], ap[:, 1:-1], ap[:, 2:]], axis=2)

    kb, vb = band(k), band(v)
    qb = q.reshape(b, nb, BLOCK, kh, g, d)
    qpos = jnp.arange(nb)[:, None] * BLOCK + jnp.arange(BLOCK)[None, :]
    kpos = jnp.arange(nb)[:, None] * BLOCK - BLOCK + jnp.arange(3 * BLOCK)[None, :]
    valid = ((jnp.abs(qpos[:, :, None] - kpos[:, None, :]) <= WINDOW)
             & (kpos[:, None, :] >= 0) & (kpos[:, None, :] < t))
    s_loc = jnp.einsum('bnqkgd,bnskd->bnkgqs', qb, kb).astype(jnp.float32)
    s_loc = jnp.where(valid[None, :, None, None], s_loc, NEG_INF)
    s_ctx = jnp.einsum('bnqkgd,bskd->bnkgqs', qb, k_ctx).astype(jnp.float32)
    p = _softmax(jnp.concatenate([s_loc, s_ctx], -1), sink[None, None, :, :, None, None]).astype(v.dtype)
    nl = 3 * BLOCK
    o = (jnp.einsum('bnkgqs,bnskd->bnqkgd', p[..., :nl], vb)
         + jnp.einsum('bnkgqs,bskd->bnqkgd', p[..., nl:], v_ctx))
    return o.reshape(b, t, kh, g, v.shape[-1])


def _retention_dir(q, k, v, log_gamma, s0, strict):
    b, t, h, dk = q.shape
    dv = v.shape[-1]
    nc = t // BLOCK
    lg = log_gamma.astype(jnp.float32)
    idx = jnp.arange(BLOCK, dtype=jnp.float32)
    diff = idx[:, None] - idx[None, :]
    mask = (diff > 0) if strict else (diff >= 0)
    dmat = jnp.where(mask[None], jnp.exp(jnp.maximum(diff, 0.0)[None] * lg[:, None, None]), 0.0)
    q_dec = jnp.exp((idx[:, None] + 1.0) * lg[None, :])
    k_dec = jnp.exp((BLOCK - 1.0 - idx)[:, None] * lg[None, :])
    c_dec = jnp.exp(BLOCK * lg)

    def chunks(a):
        return jnp.moveaxis(a.astype(jnp.float32).reshape(b, nc, BLOCK, h, a.shape[-1]), 1, 0)

    def step(state, inp):
        qc, kc, vc = inp
        att = jnp.einsum('bihd,bjhd->bhij', qc, kc) * dmat
        intra = jnp.einsum('bhij,bjhe->bihe', att, vc)
        inter = jnp.einsum('bihd,bhde->bihe', qc, state) * q_dec[None, :, :, None]
        state = (state * c_dec[None, :, None, None]
                 + jnp.einsum('bjhd,bjhe->bhde', kc * k_dec[None, :, :, None], vc))
        return state, intra + inter

    s_fin, o = lax.scan(step, s0.astype(jnp.float32), (chunks(q), chunks(k), chunks(v)))
    return jnp.moveaxis(o, 0, 1).reshape(b, t, h, dv), s_fin


def _bi_retention(q, k, v, lg_f, lg_b, s0_f, s0_b):
    o_f, s_f = _retention_dir(q, k, v, lg_f, s0_f, False)
    o_b, s_b = _retention_dir(q[:, ::-1], k[:, ::-1], v[:, ::-1], lg_b, s0_b, True)
    return o_f + o_b[:, ::-1], s_f, s_b


def _retention_out(o, gate, gain):
    mu = jnp.mean(o, -1, keepdims=True)
    var = jnp.mean(jnp.square(o - mu), -1, keepdims=True)
    y = ((o - mu) * lax.rsqrt(var + NORM_EPS)).reshape(o.shape[0], o.shape[1], -1) * gain.astype(jnp.float32)
    return jax.nn.silu(gate) * y.astype(gate.dtype)


def _project(h, lp):
    b, t, _ = h.shape
    split_at = np.cumsum(IN_SIZES)[:-1].tolist()
    (q_lat, kv_lat, k_pe, rq, rk, rv, rg, wq, wk, wv, gq, gk, gv, gates) = jnp.split(h @ lp['w_in'], split_at, axis=-1)
    qa = (_rmsnorm(q_lat, lp['mla_q_norm']) @ lp['mla_w_uq']).reshape(b, t, MLA_HEADS, MLA_NOPE + MLA_ROPE)
    return dict(
        a_q_nope=qa[..., :MLA_NOPE], a_q_pe=qa[..., MLA_NOPE:],
        a_ckv=_rmsnorm(kv_lat, lp['mla_kv_norm']), a_k_pe=k_pe,
        b_q=rq.reshape(b, t, RET_HEADS, RET_DK),
        b_k=rk.reshape(b, t, RET_HEADS, RET_DK) * (RET_DK ** -0.5),
        b_v=rv.reshape(b, t, RET_HEADS, RET_DV), b_g=rg,
        c_q=wq.reshape(b, t, WIN_HEADS, HEAD_DIM),
        c_k=wk.reshape(b, t, WIN_KV_HEADS, HEAD_DIM),
        c_v=wv.reshape(b, t, WIN_KV_HEADS, HEAD_DIM),
        d_q=_rmsnorm(gq.reshape(b, t, GQA_HEADS, HEAD_DIM), lp['gqa_q_norm']),
        d_k=_rmsnorm(gk.reshape(b, t, GQA_KV_HEADS, HEAD_DIM), lp['gqa_k_norm']),
        d_v=gv.reshape(b, t, GQA_KV_HEADS, HEAD_DIM),
        gates=gates)


def _mla_keys(ckv, k_pe, lp):
    b, s, _ = ckv.shape
    k_nope = (ckv @ lp['mla_w_uk']).reshape(b, s, MLA_HEADS, MLA_NOPE)
    v = (ckv @ lp['mla_w_uv']).reshape(b, s, MLA_HEADS, MLA_V)
    k = jnp.concatenate([k_nope, jnp.broadcast_to(k_pe[:, :, None, :], (b, s, MLA_HEADS, MLA_ROPE))], -1)
    return k, v


def _merge(outs, gates, lp):
    terms = [jax.nn.sigmoid(gates[..., i * D_MODEL:(i + 1) * D_MODEL]) * (o @ lp['w_branch'][i])
             for i, o in enumerate(outs)]
    return (terms[0] + terms[1] + terms[2] + terms[3]) @ lp['w_o']


def _context_mixer(h, lp):
    p = _project(h, lp)
    b, t, _ = h.shape
    ka, va = _mla_keys(p['a_ckv'], p['a_k_pe'], lp)
    qa = jnp.concatenate([p['a_q_nope'], p['a_q_pe']], -1) * MLA_SCALE
    o_a = _dense_attention(qa[:, :, :, None, :], ka, va)
    zeros = jnp.zeros((b, RET_HEADS, RET_DK, RET_DV), jnp.float32)
    o_b, s_f, s_b = _bi_retention(p['b_q'], p['b_k'], p['b_v'], jax.nn.log_sigmoid(lp['ret_decay_fwd']),
                                  jax.nn.log_sigmoid(lp['ret_decay_bwd']), zeros, zeros)
    o_b = _retention_out(o_b, p['b_g'], lp['ret_gn_gain'])
    sink = lp['win_sink'].reshape(WIN_KV_HEADS, WIN_GROUP)
    qc = p['c_q'].reshape(b, t, WIN_KV_HEADS, WIN_GROUP, HEAD_DIM) * ATT_SCALE
    o_c = _dense_attention(qc, p['c_k'], p['c_v'], sink)
    qd = p['d_q'].reshape(b, t, GQA_KV_HEADS, GQA_GROUP, HEAD_DIM) * ATT_SCALE
    o_d = _dense_attention(qd, p['d_k'], p['d_v'])
    y = _merge([o_a.reshape(b, t, -1), o_b, o_c.reshape(b, t, -1), o_d.reshape(b, t, -1)], p['gates'], lp)
    ctx_state = (p['a_ckv'], p['a_k_pe'], p['c_k'], p['c_v'], p['d_k'], p['d_v'],
                 s_f.astype(h.dtype), s_b.astype(h.dtype))
    return y, ctx_state


def _latent_mixer(h, lp, ckv_c, kpe_c, kc_c, vc_c, kd_c, vd_c, sf_c, sb_c):
    p = _project(h, lp)
    b, t, _ = h.shape
    cos_a, sin_a = _axial_rope(t, MLA_ROPE)
    cos_h, sin_h = _axial_rope(t, HEAD_DIM)
    q_pe = _apply_rope(p['a_q_pe'], cos_a, sin_a)
    k_pe = _apply_rope(p['a_k_pe'][:, :, None, :], cos_a, sin_a)[:, :, 0]
    ka, va = _mla_keys(jnp.concatenate([p['a_ckv'], ckv_c], 1), jnp.concatenate([k_pe, kpe_c], 1), lp)
    qa = jnp.concatenate([p['a_q_nope'], q_pe], -1) * MLA_SCALE
    o_a = _dense_attention(qa[:, :, :, None, :], ka, va)
    o_b, _, _ = _bi_retention(p['b_q'], p['b_k'], p['b_v'], jax.nn.log_sigmoid(lp['ret_decay_fwd']),
                              jax.nn.log_sigmoid(lp['ret_decay_bwd']), sf_c, sb_c)
    o_b = _retention_out(o_b, p['b_g'], lp['ret_gn_gain'])
    sink = lp['win_sink'].reshape(WIN_KV_HEADS, WIN_GROUP)
    qc = _apply_rope(p['c_q'], cos_h, sin_h).reshape(b, t, WIN_KV_HEADS, WIN_GROUP, HEAD_DIM) * ATT_SCALE
    kc = _apply_rope(p['c_k'], cos_h, sin_h)
    o_c = _banded_attention(qc, kc, p['c_v'], kc_c, vc_c, sink)
    qd = _apply_rope(p['d_q'], cos_h, sin_h).reshape(b, t, GQA_KV_HEADS, GQA_GROUP, HEAD_DIM) * ATT_SCALE
    kd = jnp.concatenate([_apply_rope(p['d_k'], cos_h, sin_h), kd_c], 1)
    vd = jnp.concatenate([p['d_v'], vd_c], 1)
    o_d = _dense_attention(qd, kd, vd)
    return _merge([o_a.reshape(b, t, -1), o_b, o_c.reshape(b, t, -1), o_d.reshape(b, t, -1)], p['gates'], lp)


def _layer(x, cond, lp, mixer_fn):
    mod = jax.nn.silu(cond) @ lp['w_ada'] + lp['b_ada']
    sh1, sc1, g1, sh2, sc2, g2 = jnp.split(mod[:, None, :], 6, axis=-1)
    y, extra = mixer_fn(x * (1 + sc1) + sh1)
    x = _layernorm(ALPHA * x + g1 * y, lp['ln1_g'], lp['ln1_b'])
    h = x * (1 + sc2) + sh2
    f = jnp.square(jax.nn.relu(h @ lp['w_up'])) @ lp['w_down']
    x = _layernorm(ALPHA * x + g2 * f, lp['ln2_g'], lp['ln2_b'])
    return x, extra


def setup_inputs(seed: int = 0) -> dict:
    key = jax.random.key(seed)
    ks = iter(jax.random.split(key, 40))

    def nrm(shape, scale):
        return scale * jax.random.normal(next(ks), shape, jnp.float32)

    base_logit = jnp.log(2.0 ** (5.0 + jnp.arange(RET_HEADS, dtype=jnp.float32)) - 1.0)
    return {
        'x_prompt': nrm((BATCH, SEQ, D_MODEL), 1.0),
        'x_sample': nrm((DEC_BATCH, DEC_SEQ, D_MODEL), 1.0),
        'cache_mla_ckv': nrm((DEC_BATCH, DEPTH, PAST_LEN, MLA_KV_RANK), 1.0),
        'cache_mla_kpe': nrm((DEC_BATCH, DEPTH, PAST_LEN, MLA_ROPE), 1.0),
        'cache_win_k': nrm((DEC_BATCH, DEPTH, PAST_LEN, WIN_KV_HEADS, HEAD_DIM), 1.0),
        'cache_win_v': nrm((DEC_BATCH, DEPTH, PAST_LEN, WIN_KV_HEADS, HEAD_DIM), 1.0),
        'cache_gqa_k': nrm((DEC_BATCH, DEPTH, PAST_LEN, GQA_KV_HEADS, HEAD_DIM), 1.0),
        'cache_gqa_v': nrm((DEC_BATCH, DEPTH, PAST_LEN, GQA_KV_HEADS, HEAD_DIM), 1.0),
        'state_ret_fwd': nrm((DEC_BATCH, DEPTH, RET_HEADS, RET_DK, RET_DV), 0.5),
        'state_ret_bwd': nrm((DEC_BATCH, DEPTH, RET_HEADS, RET_DK, RET_DV), 0.5),
        'c': nrm((DEC_BATCH, D_MODEL), 1.0),
        'c_ctx': nrm((D_MODEL,), 1.0),
        'w_ada': nrm((DEPTH, D_MODEL, 6 * D_MODEL), 0.5 * D_MODEL ** -0.5),
        'b_ada': nrm((DEPTH, 6 * D_MODEL), 0.1),
        'w_in': nrm((DEPTH, D_MODEL, IN_DIM), D_MODEL ** -0.5),
        'mla_q_norm': 1.0 + nrm((DEPTH, MLA_Q_RANK), 0.02),
        'mla_w_uq': nrm((DEPTH, MLA_Q_RANK, MLA_HEADS * (MLA_NOPE + MLA_ROPE)), MLA_Q_RANK ** -0.5),
        'mla_kv_norm': 1.0 + nrm((DEPTH, MLA_KV_RANK), 0.02),
        'mla_w_uk': nrm((DEPTH, MLA_KV_RANK, MLA_HEADS * MLA_NOPE), MLA_KV_RANK ** -0.5),
        'mla_w_uv': nrm((DEPTH, MLA_KV_RANK, MLA_HEADS * MLA_V), MLA_KV_RANK ** -0.5),
        'ret_decay_fwd': base_logit + nrm((DEPTH, RET_HEADS), 0.1),
        'ret_decay_bwd': base_logit + nrm((DEPTH, RET_HEADS), 0.1),
        'ret_gn_gain': 1.0 + nrm((DEPTH, RET_HEADS * RET_DV), 0.02),
        'win_sink': nrm((DEPTH, WIN_HEADS), 0.5),
        'gqa_q_norm': 1.0 + nrm((DEPTH, HEAD_DIM), 0.02),
        'gqa_k_norm': 1.0 + nrm((DEPTH, HEAD_DIM), 0.02),
        'w_branch': nrm((DEPTH, N_BRANCH, BRANCH_W, D_MODEL), BETA * BRANCH_W ** -0.5),
        'w_o': nrm((DEPTH, D_MODEL, D_MODEL), BETA * D_MODEL ** -0.5),
        'ln1_g': 1.0 + nrm((DEPTH, D_MODEL), 0.02),
        'ln1_b': nrm((DEPTH, D_MODEL), 0.02),
        'w_up': nrm((DEPTH, D_MODEL, D_FF), D_MODEL ** -0.5),
        'w_down': nrm((DEPTH, D_FF, D_MODEL), BETA * D_FF ** -0.5),
        'ln2_g': 1.0 + nrm((DEPTH, D_MODEL), 0.02),
        'ln2_b': nrm((DEPTH, D_MODEL), 0.02),
    }


def reference(x_prompt, x_sample, cache_mla_ckv, cache_mla_kpe, cache_win_k, cache_win_v, cache_gqa_k,
              cache_gqa_v, state_ret_fwd, state_ret_bwd, c, c_ctx, w_ada, b_ada, w_in, mla_q_norm, mla_w_uq,
              mla_kv_norm, mla_w_uk, mla_w_uv, ret_decay_fwd, ret_decay_bwd, ret_gn_gain, win_sink, gqa_q_norm,
              gqa_k_norm, w_branch, w_o, ln1_g, ln1_b, w_up, w_down, ln2_g, ln2_b):
    layers = [dict(w_ada=w_ada[l], b_ada=b_ada[l], w_in=w_in[l], mla_q_norm=mla_q_norm[l], mla_w_uq=mla_w_uq[l],
                   mla_kv_norm=mla_kv_norm[l], mla_w_uk=mla_w_uk[l], mla_w_uv=mla_w_uv[l],
                   ret_decay_fwd=ret_decay_fwd[l], ret_decay_bwd=ret_decay_bwd[l], ret_gn_gain=ret_gn_gain[l],
                   win_sink=win_sink[l], gqa_q_norm=gqa_q_norm[l], gqa_k_norm=gqa_k_norm[l],
                   w_branch=w_branch[l], w_o=w_o[l], ln1_g=ln1_g[l], ln1_b=ln1_b[l], w_up=w_up[l],
                   w_down=w_down[l], ln2_g=ln2_g[l], ln2_b=ln2_b[l]) for l in range(DEPTH)]

    xp = x_prompt
    ctx_states = []
    for l in range(DEPTH):
        lp = layers[l]
        xp, st = _layer(xp, c_ctx[None, :], lp, lambda hh, lp=lp: _context_mixer(hh, lp))
        ctx_states.append(st)
    y_prompt = xp
    new_mla_ckv = jnp.stack([s[0] for s in ctx_states], axis=1)
    new_mla_kpe = jnp.stack([s[1] for s in ctx_states], axis=1)
    new_win_k = jnp.stack([s[2] for s in ctx_states], axis=1)
    new_win_v = jnp.stack([s[3] for s in ctx_states], axis=1)
    new_gqa_k = jnp.stack([s[4] for s in ctx_states], axis=1)
    new_gqa_v = jnp.stack([s[5] for s in ctx_states], axis=1)
    new_ret_fwd = jnp.stack([s[6] for s in ctx_states], axis=1)
    new_ret_bwd = jnp.stack([s[7] for s in ctx_states], axis=1)

    xs = x_sample
    for l in range(DEPTH):
        lp = layers[l]

        def mix(hh, lp=lp, l=l):
            return _latent_mixer(hh, lp, cache_mla_ckv[:, l], cache_mla_kpe[:, l], cache_win_k[:, l],
                                 cache_win_v[:, l], cache_gqa_k[:, l], cache_gqa_v[:, l],
                                 state_ret_fwd[:, l], state_ret_bwd[:, l]), None

        xs, _ = _layer(xs, c, lp, mix)
    y_sample = xs

    return (y_prompt, y_sample, new_mla_ckv, new_mla_kpe, new_win_k, new_win_v, new_gqa_k, new_gqa_v,
            new_ret_fwd, new_ret_bwd)
```

```cpp
#define SINGLE_LAUNCH 1
#include <hip/hip_runtime.h>
#include <hip/hip_cooperative_groups.h>
#include <cstdio>
#include <cstdint>
namespace cg = cooperative_groups;

namespace pg8 {
#define PG8_LAS __attribute__((address_space(3)))
typedef unsigned short bf16_t;
typedef short bf16x8 __attribute__((ext_vector_type(8)));
typedef float f32x4 __attribute__((ext_vector_type(4)));
typedef unsigned u32x4 __attribute__((ext_vector_type(4)));
constexpr int BM = 256, BK = 64, HALF = 128, HTB = HALF * BK * 2  , STAGE_BYTES = 8 * HTB, NXCD = 8, WGM = 8;

__host__ __device__ __forceinline__ int lds_byte(int r, int c) { const int st = (r >> 4) * 2 + (c >> 5), rr = r & 15, cc = c & 31, ob = rr * 64 + cc * 2; return st * 1024 + (ob ^ (((ob >> 9) & 1) << 5)); }
__host__ __device__ __forceinline__ void stage_rc(int b, int& R, int& C) { const int st = b / 1024, sb = b % 1024, swz = sb ^ (((sb >> 9) & 1) << 5); R = (st >> 1) * 16 + swz / 64; C = (st & 1) * 32 + (swz % 64) / 2; }
__host__ __device__ __forceinline__ int perm32(int rho) { const int n = rho >> 4, i = rho & 15; return 8 * (i >> 2) + 4 * n + (i & 3); }


struct Unit { int pm, pn; };
struct Gemm { const bf16_t* A; const bf16_t* Bt; int M, N, K; int lda; int agt; size_t ago; };
__device__ __forceinline__ const char* uni_ptr(const char* p) { const unsigned long long v = (unsigned long long)p; const unsigned lo = __builtin_amdgcn_readfirstlane((unsigned)v), hi = __builtin_amdgcn_readfirstlane((unsigned)(v >> 32)); return (const char*)(((unsigned long long)hi << 32) | lo); }

struct StaticOrder {
    int nM, nN, nwg, G, c;
    __host__ __device__ void init(int M, int N, int G_, int c_) { nM = M / BM; nN = N / BM; nwg = nM * nN; G = G_; c = c_; }
    __host__ __device__ bool next(int i, Unit& u) const {
        const long L = (long)i * G + c; if (L >= nwg) return false;
        int wgid = (int)L; { const int q = nwg / NXCD, r = nwg % NXCD, xcd = wgid % NXCD, off = wgid / NXCD; wgid = (xcd < r ? xcd * (q + 1) : r * (q + 1) + (xcd - r) * q) + off; }
        const int nig = WGM * nN, gid = wgid / nig, fm = gid * WGM, gsz = (nM - fm) < WGM ? (nM - fm) : WGM;
        u.pm = fm + ((wgid % nig) % gsz); u.pn = (wgid % nig) / gsz; return true;
    }
    __device__ __forceinline__ void a_ready(const Unit&) const {}
    __device__ __forceinline__ void done(const Unit&) const {}
};
__device__ __forceinline__ unsigned cvt_pk_bf16(float lo, float hi) { unsigned r; asm volatile("v_cvt_pk_bf16_f32 %0, %1, %2" : "=v"(r) : "v"(lo), "v"(hi)); return r; }
template <class Epi, class Sched, bool ALIGN_EPI = false, bool SP2 = false>
__device__ __forceinline__ void gemm_phase(PG8_LAS unsigned char* lds, const Gemm g, const Sched& S, const Epi& E) {
    int tid_l = threadIdx.x; asm volatile("" : "+v"(tid_l)); const int tid = tid_l, wid = __builtin_amdgcn_readfirstlane(tid >> 6), lane = tid & 63, wr = wid >> 2, wc = wid & 3, fr = lane & 15, fq = lane >> 4;
    const int K = g.K, nt = K / BK;
    unsigned voffA[2], voffB[2];
#pragma unroll
    for (int i = 0; i < 2; ++i) { int R, C; stage_rc(tid * 16 + i * 8192, R, C); const int Rb = Epi::PERM ? ((R & ~31) + perm32(R & 31)) : R;
        voffA[i] = (unsigned)(R * g.lda + C) * 2u; voffB[i] = (unsigned)(Rb * K + C) * 2u; }
    const size_t kstep = (size_t)(BK * 2);
    const size_t hstepB = (size_t)HALF * K * 2, hstepA = (size_t)HALF * g.lda * 2;
    const size_t tstepB = 2 * hstepB, tstepA = 2 * hstepA;
    const unsigned ldsw = (unsigned)wid * 1024u;
    const int aoff = lds_byte(wr * 64 + fr, fq * 8), boff = lds_byte(wc * 32 + fr, fq * 8);
#define PG8_SA(b, h) (((b) * 2 + (h)) * HTB)
#define PG8_SB(b, h) ((4 + (b) * 2 + (h)) * HTB)
#define PG8_STAGE(bufoff, gbase, voff) do { _Pragma("unroll") for (int _i = 0; _i < 2; ++_i) \
        __builtin_amdgcn_global_load_lds((const unsigned*)(uni_ptr((const char*)(gbase)) + (voff)[_i]), (PG8_LAS unsigned*)(lds + (bufoff) + ldsw + _i * 8192), 16, 0, 0); } while (0)
#define PG8_LDA(dst, b, h) do { _Pragma("unroll") for (int m = 0; m < 4; ++m) _Pragma("unroll") for (int k = 0; k < 2; ++k) dst[m][k] = *(const PG8_LAS bf16x8*)(lds + PG8_SA(b, h) + aoff + m * 2048 + k * 1024); } while (0)
#define PG8_LDB(dst, b, h) do { _Pragma("unroll") for (int n = 0; n < 2; ++n) _Pragma("unroll") for (int k = 0; k < 2; ++k) dst[n][k] = *(const PG8_LAS bf16x8*)(lds + PG8_SB(b, h) + boff + n * 2048 + k * 1024); } while (0)
#define PG8_MMA(ai, bj, At, Bt) do { __builtin_amdgcn_s_setprio(1); _Pragma("unroll") for (int m = 0; m < 4; ++m) _Pragma("unroll") for (int n = 0; n < 2; ++n) _Pragma("unroll") for (int k = 0; k < 2; ++k) \
        acc[ai][bj][m][n] = __builtin_amdgcn_mfma_f32_16x16x32_bf16(Bt[n][k], At[m][k], acc[ai][bj][m][n], 0, 0, 0); __builtin_amdgcn_s_setprio(0); } while (0)
#define PG8_WAIT_V(n) asm volatile("s_waitcnt vmcnt(" #n ")" ::: "memory")
#define PG8_WAIT_L(n) asm volatile("s_waitcnt lgkmcnt(" #n ")" ::: "memory")
#define PG8_BAR __builtin_amdgcn_s_barrier()
#define PG8_SCHED __builtin_amdgcn_sched_barrier(0)
    Unit cur, nxt; int ui = 0;
    if (!S.next(0, cur)) return;
    f32x4 acc[2][2][4][2];
#pragma unroll
    for (int a = 0; a < 2; ++a)
#pragma unroll
        for (int b = 0; b < 2; ++b)
#pragma unroll
            for (int m = 0; m < 4; ++m)
#pragma unroll
                for (int n = 0; n < 2; ++n) acc[a][b][m][n] = (f32x4){0.f, 0.f, 0.f, 0.f};
    bf16x8 At[4][2], B0[2][2], B1[2][2];
    const char* cA = (const char*)g.A + (size_t)cur.pm * tstepA + (size_t)(cur.pn / g.agt) * g.ago; const char* cB = (const char*)g.Bt + (size_t)cur.pn * tstepB;
    S.a_ready(cur);
    if constexpr (SP2) {
        PG8_STAGE(PG8_SB(0, 0), cB, voffB); PG8_STAGE(PG8_SB(0, 1), cB + hstepB, voffB); PG8_STAGE(PG8_SA(0, 0), cA, voffA); PG8_STAGE(PG8_SA(0, 1), cA + hstepA, voffA);
        if (wr == 1) PG8_BAR;
        PG8_WAIT_V(2); PG8_BAR;
        PG8_STAGE(PG8_SB(1, 0), cB + kstep, voffB); PG8_STAGE(PG8_SA(1, 0), cA + kstep, voffA); PG8_STAGE(PG8_SB(1, 1), cB + hstepB + kstep, voffB);
        PG8_WAIT_V(6); PG8_BAR;
    } else {
        PG8_STAGE(PG8_SB(0, 0), cB, voffB); PG8_STAGE(PG8_SA(0, 0), cA, voffA); PG8_STAGE(PG8_SB(0, 1), cB + hstepB, voffB); PG8_STAGE(PG8_SA(0, 1), cA + hstepA, voffA);
        if (wr == 1) PG8_BAR;
        PG8_WAIT_V(4); PG8_BAR;
        PG8_STAGE(PG8_SB(1, 0), cB + kstep, voffB); PG8_STAGE(PG8_SA(1, 0), cA + kstep, voffA); PG8_STAGE(PG8_SB(1, 1), cB + hstepB + kstep, voffB);
        PG8_WAIT_V(6); PG8_BAR;
    }
    for (;;) {
        const bool has_next = S.next(ui + 1, nxt);
        const char* nA = has_next ? (const char*)g.A + (size_t)nxt.pm * tstepA + (size_t)(nxt.pn / g.agt) * g.ago : cA; const char* nB = has_next ? (const char*)g.Bt + (size_t)nxt.pn * tstepB : cB;
        for (int t = 0; t < nt; t += 2) {
            const bool last = (t == nt - 2);
            const char* a1 = cA + (size_t)(t + 1) * kstep;
            const char* a2 = last ? nA : cA + (size_t)(t + 2) * kstep; const char* b2 = last ? nB : cB + (size_t)(t + 2) * kstep;
            const char* a3 = a2 + kstep; const char* b3 = b2 + kstep;
            if (last && has_next) S.a_ready(nxt);
            if constexpr (SP2) {
            PG8_LDB(B0, 0, 0); PG8_LDB(B1, 0, 1); PG8_SCHED; PG8_LDA(At, 0, 0); PG8_STAGE(PG8_SA(1, 1), a1 + hstepA, voffA);
            PG8_WAIT_V(8); PG8_WAIT_L(0); PG8_BAR; PG8_MMA(0, 0, At, B0); PG8_MMA(0, 1, At, B1); PG8_BAR; PG8_SCHED;
            PG8_LDA(At, 0, 1); PG8_STAGE(PG8_SB(0, 0), b2, voffB); PG8_STAGE(PG8_SB(0, 1), b2 + hstepB, voffB); PG8_STAGE(PG8_SA(0, 0), a2, voffA);
            PG8_WAIT_V(8); PG8_WAIT_L(0); PG8_BAR; PG8_MMA(1, 0, At, B0); PG8_MMA(1, 1, At, B1); PG8_BAR; PG8_SCHED;
            PG8_LDB(B0, 1, 0); PG8_LDB(B1, 1, 1); PG8_SCHED; PG8_LDA(At, 1, 0); PG8_STAGE(PG8_SA(0, 1), a2 + hstepA, voffA);
            PG8_WAIT_V(8); PG8_WAIT_L(0); PG8_BAR; PG8_MMA(0, 0, At, B0); PG8_MMA(0, 1, At, B1); PG8_BAR; PG8_SCHED;
            PG8_LDA(At, 1, 1); PG8_STAGE(PG8_SB(1, 0), b3, voffB); PG8_STAGE(PG8_SB(1, 1), b3 + hstepB, voffB); PG8_STAGE(PG8_SA(1, 0), a3, voffA);
            PG8_WAIT_V(8); PG8_WAIT_L(0); PG8_BAR; PG8_MMA(1, 0, At, B0); PG8_MMA(1, 1, At, B1); PG8_BAR; PG8_SCHED;
            } else {
            PG8_LDB(B0, 0, 0); PG8_SCHED; PG8_LDA(At, 0, 0); PG8_STAGE(PG8_SA(1, 1), a1 + hstepA, voffA);
            PG8_WAIT_L(8); PG8_BAR; PG8_WAIT_L(0); PG8_MMA(0, 0, At, B0); PG8_BAR; PG8_SCHED;
            PG8_LDB(B1, 0, 1); PG8_STAGE(PG8_SB(0, 0), b2, voffB);
            PG8_BAR; PG8_WAIT_L(0); PG8_MMA(0, 1, At, B1); PG8_BAR;
            PG8_LDA(At, 0, 1); PG8_STAGE(PG8_SA(0, 0), a2, voffA);
            PG8_BAR; PG8_WAIT_L(0); PG8_MMA(1, 0, At, B0); PG8_BAR; PG8_SCHED;
            PG8_STAGE(PG8_SB(0, 1), b2 + hstepB, voffB);
            PG8_WAIT_V(6); PG8_BAR; PG8_MMA(1, 1, At, B1); PG8_BAR;
            PG8_LDB(B0, 1, 0); PG8_SCHED; PG8_LDA(At, 1, 0); PG8_STAGE(PG8_SA(0, 1), a2 + hstepA, voffA);
            PG8_WAIT_L(8); PG8_BAR; PG8_WAIT_L(0); PG8_MMA(0, 0, At, B0); PG8_BAR; PG8_SCHED;
            PG8_LDB(B1, 1, 1); PG8_STAGE(PG8_SB(1, 0), b3, voffB);
            PG8_BAR; PG8_WAIT_L(0); PG8_MMA(0, 1, At, B1); PG8_BAR;
            PG8_LDA(At, 1, 1); PG8_STAGE(PG8_SA(1, 0), a3, voffA);
            PG8_BAR; PG8_WAIT_L(0); PG8_MMA(1, 0, At, B0); PG8_BAR; PG8_SCHED;
            PG8_STAGE(PG8_SB(1, 1), b3 + hstepB, voffB);
            PG8_WAIT_V(6); PG8_BAR; PG8_MMA(1, 1, At, B1); PG8_BAR;
            }
        }
        if constexpr (ALIGN_EPI) { if (wr == 0) PG8_BAR; }
        if constexpr (!Epi::AFTER_DRAIN) { E(acc, cur, wr, wc, fr, fq); S.done(cur); }
        if (!has_next) break;
#pragma unroll
        for (int a = 0; a < 2; ++a)
#pragma unroll
            for (int b = 0; b < 2; ++b)
#pragma unroll
                for (int m = 0; m < 4; ++m)
#pragma unroll
                    for (int n = 0; n < 2; ++n) acc[a][b][m][n] = (f32x4){0.f, 0.f, 0.f, 0.f};
        cur = nxt; cA = nA; cB = nB; ++ui;
        if constexpr (ALIGN_EPI) { if (wr == 1) PG8_BAR; }
    }
    PG8_WAIT_V(0);
    if constexpr (!ALIGN_EPI) { if (wr == 0) PG8_BAR; }
    PG8_BAR;
    if constexpr (Epi::AFTER_DRAIN) { E.fused(acc, cur, wr, wc, fr, fq, lds, wid, lane); S.done(cur); }
#undef PG8_SA
#undef PG8_SB
#undef PG8_STAGE
#undef PG8_LDA
#undef PG8_LDB
#undef PG8_MMA
#undef PG8_WAIT_V
#undef PG8_WAIT_L
#undef PG8_BAR
#undef PG8_SCHED
}
}

#define LAS __attribute__((address_space(3)))
typedef unsigned short bf16;
typedef short bf16x8 __attribute__((ext_vector_type(8)));
typedef float f32x4 __attribute__((ext_vector_type(4)));
typedef unsigned u32x4 __attribute__((ext_vector_type(4)));
typedef unsigned u32x2 __attribute__((ext_vector_type(2)));

constexpr int NTHR = 512, NWAVES = 8, GRID = 256;
constexpr int M = 16384, MCTX = 8192, D = 1024, FF = 4096;
constexpr int IN_DIM = 6560, NPROJ = 2560, NGATE = 4096, NIN = NPROJ + NGATE;
constexpr int MKV = 17408;
constexpr int MKVP = 18432;
constexpr float EPS = 1e-6f, ALPHA = 1.4142135623730951f, MLA_SCALE = 0.10206207261596575f * 1.4426950408889634f  , LOG2_BASE = 13.287712379549449f;
constexpr int LDS_BYTES = 147456;

#ifndef REPMASK
#define REPMASK 0
#endif
#define NREP(kind) (((REPMASK >> (kind)) & 1) ? 2 : 1)
constexpr size_t MiB = 1u << 20;
constexpr size_t WS_MOD = 0;
constexpr size_t WS_SSQ = 256 * 1024, WS_SSKV = 512 * 1024;
constexpr size_t WS_CTR = 768 * 1024;
constexpr size_t WS_XBAR = 832 * 1024;
constexpr size_t WS_CACHE = 1 * MiB, CACHE_L = 1280 * 1024;
constexpr size_t CA_KPE = 0, CA_WK = 64 * 1024, CA_WV = 320 * 1024, CA_GK = 576 * 1024, CA_GV = 832 * 1024;
constexpr size_t WS_WIN = 4 * MiB, WS_WUQ = 17 * MiB, WS_WUKV = 17 * MiB + 256 * 1024, WS_WB = 18 * MiB, WS_WO4 = 20 * MiB, WS_WUP = 28 * MiB, WS_WDN = 36 * MiB;
constexpr size_t WS_B = 44 * MiB;
constexpr size_t WS_C = 108 * MiB;
constexpr size_t C_QL = 0, C_RQ = 8 * MiB, C_RK = 16 * MiB, C_RV = 24 * MiB, C_RG = 32 * MiB, C_WQ = 40 * MiB, C_WKV = 48 * MiB, C_GQ = 56 * MiB, C_GKV = 64 * MiB;
constexpr size_t C_CKV = 72 * MiB, C_KPE = 77 * MiB, C_QA = 78 * MiB, C_KN = 90 * MiB, C_VA = 99 * MiB;
constexpr size_t C_RVT = C_RV, C_MVT = C_VA, C_RKT = 108 * MiB, C_WVT = 116 * MiB, C_GVT = 120 * MiB;
static_assert(C_VA + (size_t)MKVP * 256 * 2 <= 128 * MiB && C_KN + (size_t)MKVP * 256 * 2 <= C_VA && C_CKV + (size_t)MKVP * 128 * 2 <= C_KPE, "region C");
constexpr size_t O_Y = 0, O_CKV = 16777216, O_KPE = 18874368, O_WK = 19398656, O_WV = 21495808, O_GK = 23592960, O_GV = 25690112, O_RF = 27787264, O_RB = 28835840;

struct Args { const float* in[34]; float* out; unsigned char* ws; int ph_lo, ph_hi; };
typedef const __attribute__((address_space(4))) Args& KARGS;
__device__ __forceinline__ const __attribute__((address_space(4))) Args* ka_fresh() { const __attribute__((address_space(4))) Args* p = (const __attribute__((address_space(4))) Args*)__builtin_amdgcn_kernarg_segment_ptr(); asm volatile("" : "+s"(p)); return p; }

__device__ __forceinline__ unsigned pk2(float lo, float hi) { unsigned r; asm("v_cvt_pk_bf16_f32 %0, %1, %2" : "=v"(r) : "v"(lo), "v"(hi)); return r; }
__device__ __forceinline__ unsigned f2bf(float f) { return pk2(f, 0.f) & 0xffffu; }
__device__ __forceinline__ float bflo(unsigned u) { return __builtin_bit_cast(float, u << 16); }
__device__ __forceinline__ float bfhi(unsigned u) { return __builtin_bit_cast(float, u & 0xffff0000u); }
__device__ __forceinline__ u32x4 pk8(const f32x4& a, const f32x4& b) { u32x4 w; w.x = pk2(a[0], a[1]); w.y = pk2(a[2], a[3]); w.z = pk2(b[0], b[1]); w.w = pk2(b[2], b[3]); return w; }
__device__ __forceinline__ void st_t8(bf16* T, size_t ld, int col0, int row, const f32x4& v0, const f32x4& v1) {
    bf16* p = T + (size_t)col0 * ld + row;
    const unsigned w0 = pk2(v0[0], v0[1]), w1 = pk2(v0[2], v0[3]), w2 = pk2(v1[0], v1[1]), w3 = pk2(v1[2], v1[3]);
    p[0] = (bf16)w0; p[ld] = (bf16)(w0 >> 16); p[2 * ld] = (bf16)w1; p[3 * ld] = (bf16)(w1 >> 16);
    p[4 * ld] = (bf16)w2; p[5 * ld] = (bf16)(w2 >> 16); p[6 * ld] = (bf16)w3; p[7 * ld] = (bf16)(w3 >> 16);
}
__device__ __forceinline__ float sigmoidf_(float x) { return 1.f / (1.f + __expf(-x)); }
__device__ __forceinline__ float sin_turns(float t) { return __builtin_amdgcn_sinf(t); }
__device__ __forceinline__ float cos_turns(float t) { return __builtin_amdgcn_cosf(t); }
__device__ __forceinline__ float rope_turns(float p, int j, float inv_nf) { const float a = p * __builtin_amdgcn_exp2f(-(float)j * inv_nf * LOG2_BASE) * 0.15915494309189535f; return a - floorf(a); }


struct EpiBase { static constexpr bool PERM = true, AFTER_DRAIN = false; };

struct EpiProj : EpiBase {
    unsigned char* ws; float* out; int l;
    const float *gq_lat, *gkv_lat, *gqn, *gkn;
    __device__ __forceinline__ void operator()(const f32x4 (&acc)[2][2][4][2], const pg8::Unit& u, int wr, int wc, int fr_, int fq_) const {
        int fr = fr_, fq = fq_; asm volatile("" : "+v"(fr), "+v"(fq));
        unsigned char* C = ws + WS_C;
        const int pn = u.pn;
        const bool isctx = u.pm < (MCTX / 256);
#pragma unroll
        for (int ai = 0; ai < 2; ++ai)
#pragma unroll
            for (int m = 0; m < 4; ++m) {
                const int row = u.pm * 256 + ai * 128 + wr * 64 + m * 16 + fr;
                f32x4 a0 = acc[ai][0][m][0], a1 = acc[ai][0][m][1], b0 = acc[ai][1][m][0], b1 = acc[ai][1][m][1];
                const int c0 = wc * 32 + fq * 8;
                const int tl = isctx ? (row & 255) : ((row - MCTX) & 2047);
                const size_t crow = isctx ? ((size_t)((row >> 8) * 2 + l) * 256 + tl) : 0;
                const float prow = (float)(tl >> 6), pcol = (float)(tl & 63);
                if (pn == 0) {
                    float ss = 0.f;
#pragma unroll
                    for (int e = 0; e < 4; ++e) ss += a0[e] * a0[e] + a1[e] * a1[e] + b0[e] * b0[e] + b1[e] * b1[e];
                    ss += __shfl_xor(ss, 16); ss += __shfl_xor(ss, 32);
                    if (fq == 0) ((float*)(ws + WS_SSQ))[row * 4 + wc] = ss;
                    const f32x4 g0 = *(const f32x4*)(gq_lat + c0), g1 = *(const f32x4*)(gq_lat + c0 + 4), g2 = *(const f32x4*)(gq_lat + 128 + c0), g3 = *(const f32x4*)(gq_lat + 128 + c0 + 4);
                    bf16* dst = (bf16*)(C + C_QL) + (size_t)row * 256;
                    *(u32x4*)(dst + c0) = pk8(a0 * g0, a1 * g1); *(u32x4*)(dst + 128 + c0) = pk8(b0 * g2, b1 * g3);
                } else if (pn == 1) {
                    float ss = 0.f;
#pragma unroll
                    for (int e = 0; e < 4; ++e) ss += a0[e] * a0[e] + a1[e] * a1[e];
                    ss += __shfl_xor(ss, 16); ss += __shfl_xor(ss, 32);
                    if (fq == 0) ((float*)(ws + WS_SSKV))[row * 4 + wc] = ss;
                    const f32x4 g0 = *(const f32x4*)(gkv_lat + c0), g1 = *(const f32x4*)(gkv_lat + c0 + 4);
                    a0 = a0 * g0; a1 = a1 * g1;
                    *(u32x4*)((bf16*)(C + C_CKV) + (size_t)row * 128 + c0) = pk8(a0, a1);
                    if (isctx) { float* o = out + O_CKV + crow * 128 + c0; *(f32x4*)o = a0; *(f32x4*)(o + 4) = a1; }
                    if (wc == 0) {
                        if (isctx) { float* o = out + O_KPE + crow * 32; *(f32x4*)(o + 4 * fq) = b0; *(f32x4*)(o + 16 + 4 * fq) = b1; }
                        else {
                            const float p = fq < 2 ? prow : pcol;
#pragma unroll
                            for (int e = 0; e < 4; ++e) { const float t = rope_turns(p, (4 * fq + e) & 7, 0.125f), cs = cos_turns(t), sn = sin_turns(t); const float x1 = b0[e], x2 = b1[e]; b0[e] = x1 * cs - x2 * sn; b1[e] = x1 * sn + x2 * cs; }
                        }
                        bf16* dst = (bf16*)(C + C_KPE) + (size_t)row * 32;
                        u32x2 w0, w1; w0.x = pk2(b0[0], b0[1]); w0.y = pk2(b0[2], b0[3]); w1.x = pk2(b1[0], b1[1]); w1.y = pk2(b1[2], b1[3]);
                        *(u32x2*)(dst + 4 * fq) = w0; *(u32x2*)(dst + 16 + 4 * fq) = w1;
                    }
                } else if (pn <= 5) {
                    if (pn == 3) { a0 = a0 * 0.125f; a1 = a1 * 0.125f; b0 = b0 * 0.125f; b1 = b1 * 0.125f; }
                    if (pn == 5) {
#pragma unroll
                        for (int e = 0; e < 4; ++e) { a0[e] *= sigmoidf_(a0[e]); a1[e] *= sigmoidf_(a1[e]); b0[e] *= sigmoidf_(b0[e]); b1[e] *= sigmoidf_(b1[e]); }
                    }
                    if (pn != 4) { bf16* dst = (bf16*)(C + C_RQ + (size_t)(pn - 2) * 8 * MiB) + (size_t)row * 256; *(u32x4*)(dst + c0) = pk8(a0, a1); *(u32x4*)(dst + 128 + c0) = pk8(b0, b1); }
                    if (pn == 3 || pn == 4) { bf16* T = (bf16*)(C + (pn == 3 ? C_RKT : C_RVT)); st_t8(T, M, c0, row, a0, a1); st_t8(T, M, 128 + c0, row, b0, b1); }
                } else {
                    const bool qtile = (pn == 6 || pn == 8), normt = (pn >= 8);
                    const bool isv = (!qtile && wc >= 2);
                    if (normt && !isv) {
                        float ss = 0.f;
#pragma unroll
                        for (int e = 0; e < 4; ++e) ss += a0[e] * a0[e] + a1[e] * a1[e] + b0[e] * b0[e] + b1[e] * b1[e];
                        ss += __shfl_xor(ss, 16); ss += __shfl_xor(ss, 32);
                        const float rs = 1.f / sqrtf(ss * (1.f / 64.f) + EPS);
                        const float* gn = qtile ? gqn : gkn;
                        const f32x4 g0 = *(const f32x4*)(gn + 8 * fq), g1 = *(const f32x4*)(gn + 8 * fq + 4), g2 = *(const f32x4*)(gn + 32 + 8 * fq), g3 = *(const f32x4*)(gn + 36 + 8 * fq);
                        a0 = a0 * g0 * rs; a1 = a1 * g1 * rs; b0 = b0 * g2 * rs; b1 = b1 * g3 * rs;
                    }
                    if (isctx && !qtile) {
                        const size_t ob = (pn == 7) ? (isv ? O_WV : O_WK) : (isv ? O_GV : O_GK);
                        float* o = out + ob + crow * 128 + (wc & 1) * 64 + 8 * fq;
                        *(f32x4*)o = a0; *(f32x4*)(o + 4) = a1; *(f32x4*)(o + 32) = b0; *(f32x4*)(o + 36) = b1;
                    }
                    if (!isctx && !isv) {
                        const float p = fq < 2 ? prow : pcol;
#pragma unroll
                        for (int e = 0; e < 4; ++e) {
                            const float t = rope_turns(p, (8 * fq + e) & 15, 0.0625f), cs = cos_turns(t), sn = sin_turns(t);
                            const float x1 = a0[e], x2 = b0[e]; a0[e] = x1 * cs - x2 * sn; b0[e] = x1 * sn + x2 * cs;
                            const float t2 = rope_turns(p, (8 * fq + 4 + e) & 15, 0.0625f), cs2 = cos_turns(t2), sn2 = sin_turns(t2);
                            const float y1 = a1[e], y2 = b1[e]; a1[e] = y1 * cs2 - y2 * sn2; b1[e] = y1 * sn2 + y2 * cs2;
                        }
                    }
                    if (qtile) { constexpr float QS = 0.125f * 1.4426950408889634f; a0 = a0 * QS; a1 = a1 * QS; b0 = b0 * QS; b1 = b1 * QS; }
                    size_t boff; int coff;
                    if (pn == 6) { boff = C_WQ; coff = wc * 64; } else if (pn == 8) { boff = C_GQ; coff = wc * 64; }
                    else { boff = (pn == 7) ? C_WKV : C_GKV; coff = (isv ? 128 : 0) + (wc & 1) * 64; }
                    if (isv) { bf16* T = (bf16*)(C + (pn == 7 ? C_WVT : C_GVT)); st_t8(T, M, (wc & 1) * 64 + 8 * fq, row, a0, a1); st_t8(T, M, (wc & 1) * 64 + 32 + 8 * fq, row, b0, b1); }
                    else { bf16* dst = (bf16*)(C + boff) + (size_t)row * 256 + coff + 8 * fq; *(u32x4*)dst = pk8(a0, a1); *(u32x4*)(dst + 32) = pk8(b0, b1); }
                }
                asm volatile("" ::: "memory"); __builtin_amdgcn_sched_barrier(0);
            }
    }
};

struct EpiQa : EpiBase {
    unsigned char* ws;
    __device__ __forceinline__ void operator()(const f32x4 (&acc)[2][2][4][2], const pg8::Unit& u, int wr, int wc, int fr_, int fq_) const {
        int fr = fr_, fq = fq_; asm volatile("" : "+v"(fr), "+v"(fq));
        bf16* QA = (bf16*)(ws + WS_C + C_QA);
        const float* ssq = (const float*)(ws + WS_SSQ);
        const bool isctx = u.pm < (MCTX / 256);
#pragma unroll
        for (int ai = 0; ai < 2; ++ai)
#pragma unroll
            for (int m = 0; m < 4; ++m) {
                const int row = u.pm * 256 + ai * 128 + wr * 64 + m * 16 + fr;
                const f32x4 s4 = *(const f32x4*)(ssq + row * 4);
                const float rs = MLA_SCALE / sqrtf(((s4[0] + s4[1]) + (s4[2] + s4[3])) * (1.f / 256.f) + EPS);
                f32x4 a0 = acc[ai][0][m][0] * rs, a1 = acc[ai][0][m][1] * rs, b0 = acc[ai][1][m][0] * rs, b1 = acc[ai][1][m][1] * rs;
                bf16* dst = QA + (size_t)row * 384;
                if (u.pn == 0) {
                    const int p0 = wc * 32 + fq * 8, p1 = 128 + p0;
                    *(u32x4*)(dst + (p0 >> 6) * 96 + (p0 & 63)) = pk8(a0, a1);
                    *(u32x4*)(dst + (p1 >> 6) * 96 + (p1 & 63)) = pk8(b0, b1);
                } else {
                    if (!isctx) {
                        const int tl = (row - MCTX) & 2047; const float p = fq < 2 ? (float)(tl >> 6) : (float)(tl & 63);
#pragma unroll
                        for (int e = 0; e < 4; ++e) { const float t = rope_turns(p, (4 * fq + e) & 7, 0.125f), cs = cos_turns(t), sn = sin_turns(t); const float x1 = a0[e], x2 = a1[e]; a0[e] = x1 * cs - x2 * sn; a1[e] = x1 * sn + x2 * cs; }
                    }
                    u32x2 w0, w1; w0.x = pk2(a0[0], a0[1]); w0.y = pk2(a0[2], a0[3]); w1.x = pk2(a1[0], a1[1]); w1.y = pk2(a1[2], a1[3]);
                    *(u32x2*)(dst + wc * 96 + 64 + 4 * fq) = w0; *(u32x2*)(dst + wc * 96 + 80 + 4 * fq) = w1;
                }
                asm volatile("" ::: "memory"); __builtin_amdgcn_sched_barrier(0);
            }
    }
};

struct EpiKv : EpiBase {
    unsigned char* ws;
    __device__ __forceinline__ void operator()(const f32x4 (&acc)[2][2][4][2], const pg8::Unit& u, int wr, int wc, int fr_, int fq_) const {
        int fr = fr_, fq = fq_; asm volatile("" : "+v"(fr), "+v"(fq));
        bf16* O = (bf16*)(ws + WS_C + (u.pn == 0 ? C_KN : C_VA));
        const float* sskv = (const float*)(ws + WS_SSKV);
        const bool tok = u.pm < (M / 256);
#pragma unroll
        for (int ai = 0; ai < 2; ++ai)
#pragma unroll
            for (int m = 0; m < 4; ++m) {
                const int row = u.pm * 256 + ai * 128 + wr * 64 + m * 16 + fr;
                float rs = 1.f;
                if (tok) { const f32x4 s4 = *(const f32x4*)(sskv + row * 4); rs = 1.f / sqrtf(((s4[0] + s4[1]) + (s4[2] + s4[3])) * (1.f / 128.f) + EPS); }
                if (u.pn == 0) { bf16* dst = O + (size_t)row * 256 + wc * 32 + fq * 8;
                    *(u32x4*)dst = pk8(acc[ai][0][m][0] * rs, acc[ai][0][m][1] * rs); *(u32x4*)(dst + 128) = pk8(acc[ai][1][m][0] * rs, acc[ai][1][m][1] * rs); }
                else { st_t8(O, MKVP, wc * 32 + fq * 8, row, acc[ai][0][m][0] * rs, acc[ai][0][m][1] * rs); st_t8(O, MKVP, 128 + wc * 32 + fq * 8, row, acc[ai][1][m][0] * rs, acc[ai][1][m][1] * rs); }
                asm volatile("" ::: "memory"); __builtin_amdgcn_sched_barrier(0);
            }
    }
};

template <int ACT> struct EpiAct : EpiBase {
    bf16* O; int ldc;
    __device__ __forceinline__ void operator()(const f32x4 (&acc)[2][2][4][2], const pg8::Unit& u, int wr, int wc, int fr_, int fq_) const {
        int fr = fr_, fq = fq_; asm volatile("" : "+v"(fr), "+v"(fq));
#pragma unroll
        for (int ai = 0; ai < 2; ++ai)
#pragma unroll
            for (int m = 0; m < 4; ++m) {
                const int row = u.pm * 256 + ai * 128 + wr * 64 + m * 16 + fr;
                bf16* dst = O + (size_t)row * ldc + u.pn * 256 + wc * 32 + fq * 8;
#pragma unroll
                for (int bj = 0; bj < 2; ++bj) {
                    f32x4 v0 = acc[ai][bj][m][0], v1 = acc[ai][bj][m][1];
#pragma unroll
                    for (int e = 0; e < 4; ++e) {
                        if (ACT == 0) { v0[e] = sigmoidf_(v0[e]); v1[e] = sigmoidf_(v1[e]); }
                        else { const float r0 = fmaxf(v0[e], 0.f), r1 = fmaxf(v1[e], 0.f); v0[e] = r0 * r0; v1[e] = r1 * r1; }
                    }
                    *(u32x4*)(dst + bj * 128) = pk8(v0, v1);
                }
                asm volatile("" ::: "memory"); __builtin_amdgcn_sched_barrier(0);
            }
    }
};

struct BranchOrder {
    int c;
    __device__ __forceinline__ bool next(int i, pg8::Unit& u) const { if (i >= 4) return false; u.pm = c >> 2; u.pn = i * 4 + (c & 3); return true; }
    __device__ __forceinline__ void a_ready(const pg8::Unit&) const {}
    __device__ __forceinline__ void done(const pg8::Unit&) const {}
};
struct EpiMerge : EpiBase {
    const bf16* GT; bf16* MG;
    __device__ __forceinline__ void operator()(const f32x4 (&acc)[2][2][4][2], const pg8::Unit& u, int wr, int wc, int fr_, int fq_) const {
        int fr = fr_, fq = fq_; asm volatile("" : "+v"(fr), "+v"(fq));
        const int br = u.pn >> 2, ct = u.pn & 3;
#pragma unroll
        for (int ai = 0; ai < 2; ++ai)
#pragma unroll
            for (int m = 0; m < 4; ++m) {
                const int row = u.pm * 256 + ai * 128 + wr * 64 + m * 16 + fr;
                const bf16* gp = GT + (size_t)row * 4096 + u.pn * 256 + wc * 32 + fq * 8;
                bf16* mp = MG + (size_t)row * 2048 + ct * 256 + wc * 32 + fq * 8;
#pragma unroll
                for (int bj = 0; bj < 2; ++bj) {
                    const u32x4 g = *(const u32x4*)(gp + bj * 128);
                    const f32x4 v0 = acc[ai][bj][m][0], v1 = acc[ai][bj][m][1];
                    float r0 = bflo(g.x) * v0[0], r1 = bfhi(g.x) * v0[1], r2 = bflo(g.y) * v0[2], r3 = bfhi(g.y) * v0[3], r4 = bflo(g.z) * v1[0], r5 = bfhi(g.z) * v1[1], r6 = bflo(g.w) * v1[2], r7 = bfhi(g.w) * v1[3];
                    if (br > 0) { const u32x4 p = *(const u32x4*)(mp + bj * 128); r0 += bflo(p.x); r1 += bfhi(p.x); r2 += bflo(p.y); r3 += bfhi(p.y); r4 += bflo(p.z); r5 += bfhi(p.z); r6 += bflo(p.w); r7 += bfhi(p.w); }
                    u32x4 w; w.x = pk2(r0, r1); w.y = pk2(r2, r3); w.z = pk2(r4, r5); w.w = pk2(r6, r7);
                    *(u32x4*)(mp + bj * 128) = w;
                }
                asm volatile("" ::: "memory"); __builtin_amdgcn_sched_barrier(0);
            }
    }
};

struct EpiRes : EpiBase {
    const float* xp; const float* xs;
    const float* gate;
    float* Z;
    __device__ __forceinline__ void operator()(const f32x4 (&acc)[2][2][4][2], const pg8::Unit& u, int wr, int wc, int fr_, int fq_) const {
        int fr = fr_, fq = fq_; asm volatile("" : "+v"(fr), "+v"(fq));
        const bool isctx = u.pm < (MCTX / 256);
        const int mr = isctx ? 0 : 1 + ((u.pm * 256 - MCTX) >> 11);
        const float* g = gate + (size_t)mr * 6144 + u.pn * 256 + wc * 32 + fq * 8;
        f32x4 gv[2][2];
#pragma unroll
        for (int bj = 0; bj < 2; ++bj) { gv[bj][0] = *(const f32x4*)(g + bj * 128); gv[bj][1] = *(const f32x4*)(g + bj * 128 + 4); }
#pragma unroll
        for (int ai = 0; ai < 2; ++ai)
#pragma unroll
            for (int m = 0; m < 4; ++m) {
                const int row = u.pm * 256 + ai * 128 + wr * 64 + m * 16 + fr;
                const float* x = (isctx ? xp + (size_t)row * 1024 : xs + (size_t)(row - MCTX) * 1024) + u.pn * 256 + wc * 32 + fq * 8;
                float* z = Z + (size_t)row * 1024 + u.pn * 256 + wc * 32 + fq * 8;
#pragma unroll
                for (int bj = 0; bj < 2; ++bj) {
                    const f32x4 x0 = *(const f32x4*)(x + bj * 128), x1 = *(const f32x4*)(x + bj * 128 + 4);
                    *(f32x4*)(z + bj * 128) = x0 * ALPHA + gv[bj][0] * acc[ai][bj][m][0];
                    *(f32x4*)(z + bj * 128 + 4) = x1 * ALPHA + gv[bj][1] * acc[ai][bj][m][1];
                }
                asm volatile("" ::: "memory"); __builtin_amdgcn_sched_barrier(0);
            }
    }
};

__device__ __forceinline__ float wave_sum(float v) {
#pragma unroll
    for (int o = 1; o < 64; o <<= 1) v += __shfl_xor(v, o);
    return v;
}

__device__ __forceinline__ int win_dst_row(int c) {
    if (c < 384) return c;
    if (c < 416) { const int j = c - 384; return 384 + ((j < 16) ? (8 * (j >> 2) + (j & 3)) : (8 * ((j - 16) >> 2) + 4 + (j & 3))); }
    if (c < 1440) return 512 + (c - 416);
    if (c < 2464) {
        int base, slot, i;
        if (c < 1696) { base = 1536; slot = (c - 1440) >> 6; i = (c - 1440) & 63; }
        else if (c < 1824) { base = 1792; slot = (c - 1696) >> 6; i = (c - 1696) & 63; }
        else if (c < 1952) { base = 1792; slot = 2 + ((c - 1824) >> 6); i = (c - 1824) & 63; }
        else if (c < 2208) { base = 2048; slot = (c - 1952) >> 6; i = (c - 1952) & 63; }
        else if (c < 2336) { base = 2304; slot = (c - 2208) >> 6; i = (c - 2208) & 63; }
        else { base = 2304; slot = 2 + ((c - 2336) >> 6); i = (c - 2336) & 63; }
        return base + 128 * (i >> 5) + 32 * slot + (i & 31);
    }
    return 2560 + (c - 2464);
}
__device__ __forceinline__ int wuq_dst_row(int c) {
    const int h = c / 96, i = c - h * 96;
    if (i < 64) return h * 64 + i;
    const int j = i - 64;
    return 256 + 32 * h + ((j < 16) ? (8 * (j >> 2) + (j & 3)) : (8 * ((j - 16) >> 2) + 4 + (j & 3)));
}

template <int MAP> __device__ __forceinline__ void tr_item(const float* W, int N, bf16* WT, int Kd, int row_off, int item, float* scr, int lane, int rep, int repstride) {
    const int nblk = N / 32, kb = item / nblk, nb = item % nblk, k0 = 64 * kb, n0 = 32 * nb;
#pragma unroll 8
    for (int i = 0; i < 32; ++i) { const int kk = 2 * i + (lane >> 5); scr[kk * 33 + (lane & 31)] = W[(size_t)(k0 + kk) * N + n0 + (lane & 31)]; }
    asm volatile("s_waitcnt lgkmcnt(0)" ::: "memory");
    const int c = lane & 7;
#pragma unroll
    for (int j = 0; j < 4; ++j) {
        const int n = (lane >> 3) + 8 * j; const float* s = scr + (8 * c) * 33 + n;
        u32x4 o; o.x = pk2(s[0 * 33], s[1 * 33]); o.y = pk2(s[2 * 33], s[3 * 33]); o.z = pk2(s[4 * 33], s[5 * 33]); o.w = pk2(s[6 * 33], s[7 * 33]);
        const int sc = n0 + n; const int dr = (MAP == 1) ? win_dst_row(sc) : (MAP == 2) ? wuq_dst_row(sc) : sc;
        bf16* d = WT + (size_t)(row_off + dr) * Kd + k0 + 8 * c;
        for (int r = 0; r < rep; ++r) *(u32x4*)(d + r * repstride) = o;
    }
    asm volatile("s_waitcnt lgkmcnt(0)" ::: "memory");
}

__device__ __forceinline__ void conv_weights(KARGS A, int l, unsigned char* lds, int gw, int NGW, int wave, int lane) {
    float* scr = (float*)(lds + 32768 + wave * 8704);
    unsigned char* ws = A.ws;
    constexpr int I_IN = 16 * 205, I_UQ = 4 * 12, I_UK = 2 * 8, I_B = 4 * 32, I_O = 16 * 32, I_UP = 16 * 128, I_DN = 64 * 32;
    constexpr int NIT = I_IN + I_UQ + 2 * I_UK + 4 * I_B + I_O + I_UP + I_DN;
    for (int it = gw; it < NIT; it += NGW) {
        int r = it;
        if (r < I_IN) { tr_item<1>(A.in[14] + (size_t)l * 1024 * IN_DIM, IN_DIM, (bf16*)(ws + WS_WIN), 1024, 0, r, scr, lane, 1, 0); continue; } r -= I_IN;
        if (r < I_UQ) { tr_item<2>(A.in[16] + (size_t)l * 256 * 384, 384, (bf16*)(ws + WS_WUQ), 256, 0, r, scr, lane, 1, 0); continue; } r -= I_UQ;
        if (r < I_UK) { tr_item<0>(A.in[18] + (size_t)l * 128 * 256, 256, (bf16*)(ws + WS_WUKV), 128, 0, r, scr, lane, 1, 0); continue; } r -= I_UK;
        if (r < I_UK) { tr_item<0>(A.in[19] + (size_t)l * 128 * 256, 256, (bf16*)(ws + WS_WUKV), 128, 256, r, scr, lane, 1, 0); continue; } r -= I_UK;
        if (r < 4 * I_B) { const int i = r / I_B; tr_item<0>(A.in[26] + (size_t)(l * 4 + i) * 256 * 1024, 1024, (bf16*)(ws + WS_WB), 256, i * 1024, r % I_B, scr, lane, 1, 0); continue; } r -= 4 * I_B;
        if (r < I_O) { tr_item<0>(A.in[27] + (size_t)l * 1024 * 1024, 1024, (bf16*)(ws + WS_WO4), 1024, 0, r, scr, lane, 1, 0); continue; } r -= I_O;
        if (r < I_UP) { tr_item<0>(A.in[30] + (size_t)l * 1024 * 4096, 4096, (bf16*)(ws + WS_WUP), 1024, 0, r, scr, lane, 1, 0); continue; } r -= I_UP;
        tr_item<0>(A.in[31] + (size_t)l * 4096 * 1024, 1024, (bf16*)(ws + WS_WDN), 4096, 0, r, scr, lane, 1, 0);
    }
}

__device__ __forceinline__ void ph0(KARGS A, unsigned char* lds) {
    int tid_l = threadIdx.x; asm volatile("" : "+v"(tid_l)); const int tid = tid_l, lane = tid & 63, wave = tid >> 6;
    const int G = GRID, gw = blockIdx.x * NWAVES + wave, NGW = G * NWAVES;
    float* mod = (float*)(A.ws + WS_MOD);
    float* sl = (float*)lds; float* red = (float*)(lds + 20480);
    for (int i = tid; i < 5 * 1024; i += NTHR) { const int r = i >> 10, k = i & 1023; const float v = (r == 0) ? A.in[11][k] : A.in[10][(r - 1) * 1024 + k]; sl[i] = v / (1.f + __expf(-v)); }
    __syncthreads();
    for (int item = blockIdx.x; item < 192; item += G) {
        const int l = item / 96, cgp = item % 96, col = cgp * 64 + lane;
        const float* W = A.in[12] + ((size_t)l * 1024 + 128 * wave) * 6144 + col;
        float a0 = 0.f, a1 = 0.f, a2 = 0.f, a3 = 0.f, a4 = 0.f;
#pragma unroll 8
        for (int kk = 0; kk < 128; ++kk) { const float w = W[(size_t)kk * 6144]; const int k = 128 * wave + kk; a0 += sl[k] * w; a1 += sl[1024 + k] * w; a2 += sl[2048 + k] * w; a3 += sl[3072 + k] * w; a4 += sl[4096 + k] * w; }
        red[(wave * 5 + 0) * 64 + lane] = a0; red[(wave * 5 + 1) * 64 + lane] = a1; red[(wave * 5 + 2) * 64 + lane] = a2; red[(wave * 5 + 3) * 64 + lane] = a3; red[(wave * 5 + 4) * 64 + lane] = a4;
        __syncthreads();
        if (tid < 320) { const int r = tid >> 6; float s = 0.f;
#pragma unroll
            for (int w = 0; w < 8; ++w) s += red[(w * 5 + r) * 64 + lane];
            mod[((size_t)l * 5 + r) * 6144 + cgp * 64 + lane] = s + A.in[13][l * 6144 + cgp * 64 + lane]; }
        __syncthreads();
    }
    conv_weights(A, 0, lds, gw, NGW, wave, lane);
    const int gt = blockIdx.x * NTHR + tid, NGT = G * NTHR;
    for (int l = 0; l < 2; ++l) {
        unsigned char* cb = A.ws + WS_CACHE + (size_t)l * CACHE_L;
        for (int i = gt; i < 1024 * 32; i += NGT) { const int r = i >> 5, c = i & 31, b = r >> 8, s = r & 255; ((bf16*)(cb + CA_KPE))[i] = (bf16)f2bf(A.in[3][((size_t)(b * 2 + l) * 256 + s) * 32 + c]); }
        for (int i = gt; i < 1024 * 128; i += NGT) { const int r = i >> 7, c = i & 127, b = r >> 8, s = r & 255; const size_t si = ((size_t)(b * 2 + l) * 256 + s) * 128 + c;
            ((bf16*)(cb + CA_WK))[i] = (bf16)f2bf(A.in[4][si]); ((bf16*)(cb + CA_GK))[i] = (bf16)f2bf(A.in[6][si]);
            ((bf16*)(cb + CA_WV))[c * 1024 + r] = (bf16)f2bf(A.in[5][si]); ((bf16*)(cb + CA_GV))[c * 1024 + r] = (bf16)f2bf(A.in[7][si]); }
    }
    if (blockIdx.x == 0 && tid < 64) ((unsigned*)(A.ws + WS_CTR))[tid] = 0u;
}

template <int MODE> __device__ __forceinline__ void rowpass(KARGS A, int l, bool do_mod, int modl, int mod_sh_off, const float* zsrc) {
    int tid_l = threadIdx.x; asm volatile("" : "+v"(tid_l)); const int tid = tid_l, lane = tid & 63, wave = tid >> 6;
    const int gw = blockIdx.x * NWAVES + wave, NGW = GRID * NWAVES;
    const float* mod = (const float*)(A.ws + WS_MOD);
    const float* lg = (MODE == 1) ? A.in[28] + l * 1024 : A.in[32] + l * 1024;
    const float* lb = (MODE == 1) ? A.in[29] + l * 1024 : A.in[33] + l * 1024;
    for (int m = gw; m < M; m += NGW) {
        const float* src = (MODE == 0) ? ((m < MCTX) ? A.in[0] + (size_t)m * 1024 : A.in[1] + (size_t)(m - MCTX) * 1024) : zsrc + (size_t)m * 1024;
        f32x4 v[4];
#pragma unroll
        for (int j = 0; j < 4; ++j) v[j] = *((const f32x4*)src + lane + 64 * j);
        if (MODE != 0) {
            float s = 0.f;
#pragma unroll
            for (int j = 0; j < 4; ++j) s += (v[j][0] + v[j][1]) + (v[j][2] + v[j][3]);
            const float mean = wave_sum(s) * (1.f / 1024.f); float s2 = 0.f;
#pragma unroll
            for (int j = 0; j < 4; ++j) { v[j] = v[j] - mean; s2 += (v[j][0] * v[j][0] + v[j][1] * v[j][1]) + (v[j][2] * v[j][2] + v[j][3] * v[j][3]); }
            const float rstd = 1.f / sqrtf(wave_sum(s2) * (1.f / 1024.f) + EPS);
            float* yo = A.out + O_Y + (size_t)m * 1024;
#pragma unroll
            for (int j = 0; j < 4; ++j) { const f32x4 g = *((const f32x4*)lg + lane + 64 * j), b = *((const f32x4*)lb + lane + 64 * j); v[j] = v[j] * rstd * g + b; *((f32x4*)yo + lane + 64 * j) = v[j]; }
        }
        if (do_mod) {
            const int mr = (m < MCTX) ? 0 : 1 + ((m - MCTX) >> 11);
            const float* sh = mod + ((size_t)modl * 5 + mr) * 6144 + mod_sh_off; const float* sc = sh + 1024;
            bf16* ho = (bf16*)(A.ws + WS_B + (size_t)m * 4096);
#pragma unroll
            for (int j = 0; j < 4; ++j) { const f32x4 a = *((const f32x4*)sh + lane + 64 * j), c = *((const f32x4*)sc + lane + 64 * j); const f32x4 h = v[j] * (c + 1.f) + a;
                u32x2 w; w.x = pk2(h[0], h[1]); w.y = pk2(h[2], h[3]); *((u32x2*)ho + lane + 64 * j) = w; }
        }
    }
}

struct ASeg { const bf16* k1; const bf16* k2; const bf16* v; int k1s, k2s, vs, nt; };
#define MFMA16(a, b, c) __builtin_amdgcn_mfma_f32_16x16x32_bf16((a), (b), (c), 0, 0, 0)

template <int DQ> __device__ __forceinline__ void attn_unit(unsigned char* lds, const bf16* q, int qs, const ASeg s0, const ASeg s1, const int band, int qpos0, int kpos0, float m0, float l0, bf16* o, int os) {
    constexpr int KSTR = DQ + 8, NKS = DQ / 32, VSTR = 72;
    int tid_l = threadIdx.x; asm volatile("" : "+v"(tid_l)); const int tid = tid_l, lane = tid & 63, w = __builtin_amdgcn_readfirstlane(tid >> 6), i = lane & 15, fq = lane >> 4;
    bf16* Kl = (bf16*)lds; bf16* Vl = (bf16*)(lds + 16384);
    bf16x8 qf[NKS];
#pragma unroll
    for (int ks = 0; ks < NKS; ++ks) qf[ks] = *(const bf16x8*)(q + (size_t)(16 * w + i) * qs + 32 * ks + 8 * fq);
    f32x4 oacc[4];
#pragma unroll
    for (int t = 0; t < 4; ++t) oacc[t] = (f32x4){0.f, 0.f, 0.f, 0.f};
    float mrun = m0, lrun = (fq == 0) ? l0 : 0.f;
    const int ntot = s0.nt + s1.nt;
    const int skey = tid >> 3, sc8 = tid & 7, skey2 = tid >> 2, sc4 = tid & 3;
    u32x4 ak1, ak2 = (u32x4){0u, 0u, 0u, 0u}, av, bk1 = ak2, bk2 = ak2, bv = ak2;
#define ATT_LOAD(K1, K2, V, TT_) do { const bool in0_ = (TT_) < s0.nt; const ASeg& sg_ = in0_ ? s0 : s1; const int tl_ = in0_ ? (TT_) : ((TT_) - s0.nt); \
        K1 = *(const u32x4*)(sg_.k1 + (size_t)(tl_ * 64 + skey) * sg_.k1s + 8 * sc8); V = *(const u32x4*)(sg_.v + (size_t)skey * sg_.vs + tl_ * 64 + 8 * sc8); \
        if (DQ == 96 && tid < 256) K2 = *(const u32x4*)(sg_.k2 + (size_t)(tl_ * 64 + skey2) * sg_.k2s + 8 * sc4); } while (0)
#define ATT_STORE(K1, K2, V) do { *(u32x4*)(Kl + skey * KSTR + 8 * sc8) = K1; if (DQ == 96 && tid < 256) *(u32x4*)(Kl + skey2 * KSTR + 64 + 8 * sc4) = K2; *(u32x4*)(Vl + skey * VSTR + 8 * sc8) = V; } while (0)
#define ATT_COMPUTE(TT_) do { \
         \
        f32x4 s[4]; \
_Pragma("unroll") \
        for (int jt = 0; jt < 4; ++jt) { \
            s[jt] = (f32x4){0.f, 0.f, 0.f, 0.f}; \
_Pragma("unroll") \
            for (int ks = 0; ks < NKS; ++ks) { const bf16x8 kf = *(const bf16x8*)(Kl + (16 * jt + i) * KSTR + 32 * ks + 8 * fq); s[jt] = MFMA16(kf, qf[ks], s[jt]); } \
        } \
        if (band && (TT_) < s0.nt) { \
            const int kb = kpos0 + 64 * (TT_) + 4 * fq; \
_Pragma("unroll") \
            for (int jt = 0; jt < 4; ++jt) \
_Pragma("unroll") \
                for (int r = 0; r < 4; ++r) { const int dd = qpos - (kb + 16 * jt + r); if (dd > 128 || dd < -128) s[jt][r] = -1e30f; } \
        } \
        float mx = -1e30f; \
_Pragma("unroll") \
        for (int jt = 0; jt < 4; ++jt) mx = fmaxf(mx, fmaxf(fmaxf(s[jt][0], s[jt][1]), fmaxf(s[jt][2], s[jt][3]))); \
        mx = fmaxf(mx, __shfl_xor(mx, 16)); mx = fmaxf(mx, __shfl_xor(mx, 32)); \
        const float mnew = fmaxf(mrun, mx), alpha = __builtin_amdgcn_exp2f(mrun - mnew); \
        mrun = mnew; \
        float ps = 0.f; \
        if (band) { \
_Pragma("unroll") \
            for (int jt = 0; jt < 4; ++jt) \
_Pragma("unroll") \
                for (int r = 0; r < 4; ++r) { const float p = (s[jt][r] < -1e29f) ? 0.f : __builtin_amdgcn_exp2f(s[jt][r] - mnew); s[jt][r] = p; ps += p; } \
        } else { \
_Pragma("unroll") \
            for (int jt = 0; jt < 4; ++jt) \
_Pragma("unroll") \
                for (int r = 0; r < 4; ++r) { const float p = __builtin_amdgcn_exp2f(s[jt][r] - mnew); s[jt][r] = p; ps += p; } \
        } \
        lrun = lrun * alpha + ps; \
_Pragma("unroll") \
        for (int t = 0; t < 4; ++t) oacc[t] = oacc[t] * alpha; \
_Pragma("unroll") \
        for (int k2 = 0; k2 < 2; ++k2) { \
            u32x4 pw; pw.x = pk2(s[2 * k2][0], s[2 * k2][1]); pw.y = pk2(s[2 * k2][2], s[2 * k2][3]); pw.z = pk2(s[2 * k2 + 1][0], s[2 * k2 + 1][1]); pw.w = pk2(s[2 * k2 + 1][2], s[2 * k2 + 1][3]); \
            const bf16x8 pb = __builtin_bit_cast(bf16x8, pw); \
_Pragma("unroll") \
            for (int t = 0; t < 4; ++t) { \
                const bf16* vp = Vl + (16 * t + i) * VSTR + 32 * k2 + 4 * fq; \
                const u32x2 va = *(const u32x2*)vp, vb = *(const u32x2*)(vp + 16); \
                u32x4 vw; vw.x = va.x; vw.y = va.y; vw.z = vb.x; vw.w = vb.y; \
                oacc[t] = MFMA16(__builtin_bit_cast(bf16x8, vw), pb, oacc[t]); \
            } \
        } \
 \
} while (0)
    const int qpos = qpos0 + 16 * w + i;
    ATT_LOAD(ak1, ak2, av, 0);
    if (ntot > 1) ATT_LOAD(bk1, bk2, bv, 1);
    for (int tt = 0; tt < ntot; tt += 2) {
        __syncthreads();
        ATT_STORE(ak1, ak2, av);
        __syncthreads();
        if (tt + 2 < ntot) ATT_LOAD(ak1, ak2, av, tt + 2);
        ATT_COMPUTE(tt);
        if (tt + 1 < ntot) {
            __syncthreads();
            ATT_STORE(bk1, bk2, bv);
            __syncthreads();
            if (tt + 3 < ntot) ATT_LOAD(bk1, bk2, bv, tt + 3);
            ATT_COMPUTE(tt + 1);
        }
    }
#undef ATT_LOAD
#undef ATT_STORE
#undef ATT_COMPUTE
    lrun += __shfl_xor(lrun, 16); lrun += __shfl_xor(lrun, 32);
    const float inv = 1.f / lrun;
    bf16* od = o + (size_t)(16 * w + i) * os + 4 * fq;
#pragma unroll
    for (int t = 0; t < 4; ++t) { u32x2 wv; wv.x = pk2(oacc[t][0] * inv, oacc[t][1] * inv); wv.y = pk2(oacc[t][2] * inv, oacc[t][3] * inv); *(u32x2*)(od + 16 * t) = wv; }
}

__device__ __forceinline__ void ret_unit(KARGS A, unsigned char* lds, int l, bool isctx, int b, int h) {
    constexpr int KS = 72, TS = 136;
    int tid_l = threadIdx.x; asm volatile("" : "+v"(tid_l)); const int tid = tid_l, lane = tid & 63, w = __builtin_amdgcn_readfirstlane(tid >> 6), i = lane & 15, fq = lane >> 4;
    bf16* Kl = (bf16*)lds; bf16* Ktl = (bf16*)(lds + 18432); bf16* Vtl = (bf16*)(lds + 35840); bf16* Stl = (bf16*)(lds + 53248);
    unsigned char* C = A.ws + WS_C;
    const int T = isctx ? 256 : 2048, nc = T / 128, base = isctx ? b * 256 : MCTX + b * 2048;
    const bf16* RQ = (const bf16*)(C + C_RQ) + h * 64; const bf16* RK = (const bf16*)(C + C_RK) + h * 64; const bf16* RKT = (const bf16*)(C + C_RKT) + (size_t)(h * 64) * M; const bf16* RVT = (const bf16*)(C + C_RVT) + (size_t)(h * 64) * M; const bf16* RG = (const bf16*)(C + C_RG) + h * 64;
    bf16* OB = (bf16*)(A.ws + WS_B) + 1024 + 256 + h * 64;
    const float* gain = A.in[22] + l * 256 + h * 64;
    const int dt0 = (2 * w) >> 2, et0 = (2 * w) & 3, et1 = et0 + 1;
    for (int dir = 0; dir < 2; ++dir) {
        const float xdec = A.in[dir == 0 ? 20 : 21][l * 4 + h];
        const float l2g = -log1pf(__expf(-xdec)) * 1.4426950408889634f;
        f32x4 st[2];
        if (isctx) { st[0] = (f32x4){0.f, 0.f, 0.f, 0.f}; st[1] = st[0]; }
        else {
            const float* s0 = A.in[dir == 0 ? 8 : 9] + ((size_t)(b * 2 + l) * 4 + h) * 4096;
#pragma unroll
            for (int r = 0; r < 4; ++r) { st[0][r] = s0[(16 * dt0 + 4 * fq + r) * 64 + 16 * et0 + i]; st[1][r] = s0[(16 * dt0 + 4 * fq + r) * 64 + 16 * et1 + i]; }
        }
        __syncthreads();
        { u32x2 w0, w1; w0.x = pk2(st[0][0], st[0][1]); w0.y = pk2(st[0][2], st[0][3]); w1.x = pk2(st[1][0], st[1][1]); w1.y = pk2(st[1][2], st[1][3]);
          *(u32x2*)(Stl + (16 * et0 + i) * KS + 16 * dt0 + 4 * fq) = w0; *(u32x2*)(Stl + (16 * et1 + i) * KS + 16 * dt0 + 4 * fq) = w1; }
        const float cdec = __builtin_amdgcn_exp2f(128.f * l2g);
        for (int c = 0; c < nc; ++c) {
            const int ca = (dir == 0) ? c : nc - 1 - c; const int r0 = base + 128 * ca;
#pragma unroll
            for (int rep = 0; rep < 2; ++rep) {
                const int idx = tid + NTHR * rep, tok = idx >> 3, c8 = idx & 7, rowd = idx >> 4, c16 = idx & 15;
                *(u32x4*)(Kl + tok * KS + 8 * c8) = *(const u32x4*)(RK + (size_t)(r0 + tok) * 256 + 8 * c8);
                *(u32x4*)(Ktl + rowd * TS + 8 * c16) = *(const u32x4*)(RKT + (size_t)rowd * M + r0 + 8 * c16);
                *(u32x4*)(Vtl + rowd * TS + 8 * c16) = *(const u32x4*)(RVT + (size_t)rowd * M + r0 + 8 * c16);
            }
            bf16x8 qf[2];
#pragma unroll
            for (int ks = 0; ks < 2; ++ks) qf[ks] = *(const bf16x8*)(RQ + (size_t)(r0 + 16 * w + i) * 256 + 32 * ks + 8 * fq);
            __syncthreads();
            f32x4 oacc[4];
#pragma unroll
            for (int t = 0; t < 4; ++t) oacc[t] = (f32x4){0.f, 0.f, 0.f, 0.f};
            const int ia = 16 * w + i;
#pragma unroll
            for (int k2 = 0; k2 < 4; ++k2) {
                const bool need = (dir == 0) ? (2 * k2 <= w) : (2 * k2 + 1 >= w);
                if (need) {
                    f32x4 s[2];
#pragma unroll
                    for (int j2 = 0; j2 < 2; ++j2) {
                        const int jt = 2 * k2 + j2;
                        s[j2] = (f32x4){0.f, 0.f, 0.f, 0.f};
#pragma unroll
                        for (int ks = 0; ks < 2; ++ks) { const bf16x8 kf = *(const bf16x8*)(Kl + (16 * jt + i) * KS + 32 * ks + 8 * fq); s[j2] = MFMA16(kf, qf[ks], s[j2]); }
#pragma unroll
                        for (int r = 0; r < 4; ++r) {
                            const int ja = 16 * jt + 4 * fq + r; const int df = (dir == 0) ? (ia - ja) : (ja - ia);
                            const bool ok = (dir == 0) ? (df >= 0) : (df > 0);
                            s[j2][r] = ok ? s[j2][r] * __builtin_amdgcn_exp2f(l2g * (float)df) : 0.f;
                        }
                    }
                    u32x4 pw; pw.x = pk2(s[0][0], s[0][1]); pw.y = pk2(s[0][2], s[0][3]); pw.z = pk2(s[1][0], s[1][1]); pw.w = pk2(s[1][2], s[1][3]);
                    const bf16x8 pb = __builtin_bit_cast(bf16x8, pw);
#pragma unroll
                    for (int t = 0; t < 4; ++t) {
                        const bf16* vp = Vtl + (16 * t + i) * TS + 32 * k2 + 4 * fq;
                        const u32x2 va = *(const u32x2*)vp, vb = *(const u32x2*)(vp + 16);
                        u32x4 vw; vw.x = va.x; vw.y = va.y; vw.z = vb.x; vw.w = vb.y;
                        oacc[t] = MFMA16(__builtin_bit_cast(bf16x8, vw), pb, oacc[t]);
                    }
                }
            }
            {
                const float qd = __builtin_amdgcn_exp2f(l2g * (float)((dir == 0) ? (ia + 1) : (128 - ia)));
#pragma unroll
                for (int t = 0; t < 4; ++t) {
                    f32x4 oi = (f32x4){0.f, 0.f, 0.f, 0.f};
#pragma unroll
                    for (int ks = 0; ks < 2; ++ks) { const bf16x8 sf = *(const bf16x8*)(Stl + (16 * t + i) * KS + 32 * ks + 8 * fq); oi = MFMA16(sf, qf[ks], oi); }
                    oacc[t] = oacc[t] + oi * qd;
                }
            }
            {
                bf16* od = OB + (size_t)(r0 + ia) * 2048 + 4 * fq;
                if (dir == 0) {
#pragma unroll
                    for (int t = 0; t < 4; ++t) { u32x2 wv; wv.x = pk2(oacc[t][0], oacc[t][1]); wv.y = pk2(oacc[t][2], oacc[t][3]); *(u32x2*)(od + 16 * t) = wv; }
                } else {
                    float sm = 0.f;
#pragma unroll
                    for (int t = 0; t < 4; ++t) { const u32x2 pf = *(const u32x2*)(od + 16 * t); oacc[t][0] += bflo(pf.x); oacc[t][1] += bfhi(pf.x); oacc[t][2] += bflo(pf.y); oacc[t][3] += bfhi(pf.y);
                        sm += (oacc[t][0] + oacc[t][1]) + (oacc[t][2] + oacc[t][3]); }
                    sm += __shfl_xor(sm, 16); sm += __shfl_xor(sm, 32);
                    const float mu = sm * (1.f / 64.f); float sq = 0.f;
#pragma unroll
                    for (int t = 0; t < 4; ++t) { oacc[t] = oacc[t] - mu; sq += (oacc[t][0] * oacc[t][0] + oacc[t][1] * oacc[t][1]) + (oacc[t][2] * oacc[t][2] + oacc[t][3] * oacc[t][3]); }
                    sq += __shfl_xor(sq, 16); sq += __shfl_xor(sq, 32);
                    const float rstd = 1.f / sqrtf(sq * (1.f / 64.f) + EPS);
                    const bf16* gp = RG + (size_t)(r0 + ia) * 256 + 4 * fq;
#pragma unroll
                    for (int t = 0; t < 4; ++t) { const u32x2 gg = *(const u32x2*)(gp + 16 * t); const f32x4 gn = *(const f32x4*)(gain + 16 * t + 4 * fq);
                        u32x2 wv; wv.x = pk2(bflo(gg.x) * oacc[t][0] * rstd * gn[0], bfhi(gg.x) * oacc[t][1] * rstd * gn[1]); wv.y = pk2(bflo(gg.y) * oacc[t][2] * rstd * gn[2], bfhi(gg.y) * oacc[t][3] * rstd * gn[3]);
                        *(u32x2*)(od + 16 * t) = wv; }
                }
            }
            __syncthreads();
            st[0] = st[0] * cdec; st[1] = st[1] * cdec;
#pragma unroll
            for (int ks = 0; ks < 4; ++ks) {
                const u32x4 kr = *(const u32x4*)(Ktl + (16 * dt0 + i) * TS + 32 * ks + 8 * fq);
                const int j0 = 32 * ks + 8 * fq;
                float dk[8];
#pragma unroll
                for (int e = 0; e < 8; ++e) dk[e] = __builtin_amdgcn_exp2f(l2g * (float)((dir == 0) ? (127 - j0 - e) : (j0 + e)));
                u32x4 kw; kw.x = pk2(bflo(kr.x) * dk[0], bfhi(kr.x) * dk[1]); kw.y = pk2(bflo(kr.y) * dk[2], bfhi(kr.y) * dk[3]); kw.z = pk2(bflo(kr.z) * dk[4], bfhi(kr.z) * dk[5]); kw.w = pk2(bflo(kr.w) * dk[6], bfhi(kr.w) * dk[7]);
                const bf16x8 kf = __builtin_bit_cast(bf16x8, kw);
                st[0] = MFMA16(kf, *(const bf16x8*)(Vtl + (16 * et0 + i) * TS + 32 * ks + 8 * fq), st[0]);
                st[1] = MFMA16(kf, *(const bf16x8*)(Vtl + (16 * et1 + i) * TS + 32 * ks + 8 * fq), st[1]);
            }
#pragma unroll
            for (int j = 0; j < 2; ++j) { u32x2 w0; w0.x = pk2(st[j][0], st[j][1]); w0.y = pk2(st[j][2], st[j][3]); *(u32x2*)(Stl + (16 * (et0 + j) + i) * KS + 16 * dt0 + 4 * fq) = w0; }
            __syncthreads();
        }
        if (isctx) {
            float* so = A.out + (dir == 0 ? O_RF : O_RB) + ((size_t)(b * 2 + l) * 4 + h) * 4096;
#pragma unroll
            for (int r = 0; r < 4; ++r) { so[(16 * dt0 + 4 * fq + r) * 64 + 16 * et0 + i] = st[0][r]; so[(16 * dt0 + 4 * fq + r) * 64 + 16 * et1 + i] = st[1][r]; }
        }
    }
}

constexpr int NU_ATT = 1680;
__device__ __forceinline__ void attn_dispatch(KARGS A, unsigned char* lds, int l, int u) {
    unsigned char* C = A.ws + WS_C; unsigned char* cb = A.ws + WS_CACHE + (size_t)l * CACHE_L;
    bf16* OBASE = (bf16*)(A.ws + WS_B) + 1024;
    if (u < 16 || (u >= 784 && u < 912)) { const bool rc = (u >= 784); const int v = rc ? u - 784 : u; for (int rr = 0; rr < ((REPMASK & 0x10000) && !rc ? 2 : 1); ++rr) ret_unit(A, lds, l, rc, v >> 2, v & 3); return; }
    int type, b, h, n; bool isctx;
    if (u < 784) { const int v = (u - 16) & 255; type = (u < 272) ? 0 : (u < 528) ? 2 : 1; b = v >> 6; h = (v >> 4) & 3; n = v & 15; isctx = false; }
    else { const int v = u - 912; type = v >> 8; b = (v & 255) >> 3; h = (v >> 1) & 3; n = v & 1; isctx = true; }
    const int T = isctx ? 256 : 2048, base = isctx ? b * 256 : MCTX + b * 2048, q0 = base + 128 * n;
    ASeg s0, s1; s1.nt = 0; s1.k1 = nullptr; s1.k2 = nullptr; s1.v = nullptr; s1.k1s = 0; s1.k2s = 0; s1.vs = 0;
    if (type == 0) {
        const bf16* KN = (const bf16*)(C + C_KN) + h * 64; const bf16* MVT = (const bf16*)(C + C_MVT) + (size_t)(h * 64) * MKVP; const bf16* KPE = (const bf16*)(C + C_KPE);
        s0.k1 = KN + (size_t)base * 256; s0.k1s = 256; s0.k2 = KPE + (size_t)base * 32; s0.k2s = 32; s0.v = MVT + base; s0.vs = MKVP; s0.nt = T / 64;
        if (!isctx) { s1.k1 = KN + (size_t)(M + b * 256) * 256; s1.k1s = 256; s1.k2 = (const bf16*)(cb + CA_KPE) + (size_t)(b * 256) * 32; s1.k2s = 32; s1.v = MVT + (M + b * 256); s1.vs = MKVP; s1.nt = 4; }
        attn_unit<96>(lds, (const bf16*)(C + C_QA) + (size_t)q0 * 384 + h * 96, 384, s0, s1, 0, 0, 0, -1e30f, 0.f, OBASE + (size_t)q0 * 2048 + h * 64, 2048);
    } else {
        const int kh = h >> 1; const bool win = (type == 1);
        const bf16* KV = (const bf16*)(C + (win ? C_WKV : C_GKV)) + kh * 64;
        int klo = 0, khi = T;
        if (win && !isctx) { klo = 128 * (n - 1); if (klo < 0) klo = 0; khi = 128 * (n + 2); if (khi > T) khi = T; }
        s0.k1 = KV + (size_t)(base + klo) * 256; s0.k1s = 256; s0.k2 = nullptr; s0.k2s = 0; s0.v = (const bf16*)(C + (win ? C_WVT : C_GVT)) + (size_t)(kh * 64) * M + base + klo; s0.vs = M; s0.nt = (khi - klo) / 64;
        if (!isctx) { s1.k1 = (const bf16*)(cb + (win ? CA_WK : CA_GK)) + (size_t)(b * 256) * 128 + kh * 64; s1.k1s = 128; s1.v = (const bf16*)(cb + (win ? CA_WV : CA_GV)) + (size_t)(kh * 64) * 1024 + b * 256; s1.vs = 1024; s1.nt = 4; }
        float m0 = -1e30f, l0 = 0.f;
        if (win) { m0 = A.in[23][l * 4 + h] * 1.4426950408889634f; l0 = 1.f; }
        attn_unit<64>(lds, (const bf16*)(C + (win ? C_WQ : C_GQ)) + (size_t)q0 * 256 + h * 64, 256, s0, s1, (win && !isctx) ? 1 : 0, 128 * n, klo, m0, l0, OBASE + (size_t)q0 * 2048 + (win ? 512 : 768) + h * 64, 2048);
    }
}

#define XB_TMO      128
#define XB_XCNT(j)  (256  + 64 * (j))
#define XB_XSUB(j)  (1280 + 64 * (j))
#define XB_XGEN(j)  (2304 + 64 * (j))
#define XB_TOP      3328
#define XB_TOPGEN   3392
#define XCD_BAR_WORDS 3456
#define XB_SPIN_CAP (1u << 18)

__device__ __forceinline__ unsigned xb_ld(unsigned* p)              { return __hip_atomic_load(p, __ATOMIC_RELAXED, __HIP_MEMORY_SCOPE_AGENT); }
__device__ __forceinline__ unsigned xb_add(unsigned* p, unsigned v) { return __hip_atomic_fetch_add(p, v, __ATOMIC_RELAXED, __HIP_MEMORY_SCOPE_AGENT); }
__device__ __forceinline__ unsigned xb_xcc_id() { return (unsigned)__builtin_amdgcn_s_getreg((3 << 11) | 20) & 0xFu; }
#define XB_SPIN(cond, bar) do { unsigned _sp = 0; while (cond) { __builtin_amdgcn_s_sleep(1); \
    if ((++_sp & 255u) == 0u) { if (xb_ld(&(bar)[XB_TMO])) break; if (_sp > XB_SPIN_CAP) { atomicAdd(&(bar)[XB_TMO], 1u); break; } } } } while (0)

struct XcdBarrier {
    unsigned* bar; unsigned x;
    volatile LAS unsigned* st;
};

__device__ __forceinline__ XcdBarrier xcd_barrier_post(unsigned* bar, volatile LAS unsigned* st) {
    XcdBarrier b; b.bar = bar; b.x = xb_xcc_id(); b.st = st;
    if (threadIdx.x == 0) (void)xb_add(&bar[XB_XCNT(b.x)], 1u);
    return b;
}
__device__ __forceinline__ void xcd_barrier_complete(unsigned* bar, unsigned x, unsigned& nloc, unsigned& nx) {
    const unsigned G = gridDim.x * gridDim.y * gridDim.z;
    unsigned sum, cnt, mine, sp = 0u;
    for (;;) {
        sum = 0u; cnt = 0u; mine = 0u;
#pragma unroll
        for (unsigned j = 0; j < 16; ++j) { const unsigned c = xb_ld(&bar[XB_XCNT(j)]); sum += c; cnt += (c > 0u) ? 1u : 0u; mine = (j == x) ? c : mine; }
        if (sum == G) break;
        __builtin_amdgcn_s_sleep(1);
        if ((++sp & 255u) == 0u) { if (xb_ld(&bar[XB_TMO])) break; if (sp > XB_SPIN_CAP) { atomicAdd(&bar[XB_TMO], 1u); break; } }
    }
    nloc = mine > 0u ? mine : 1u; nx = cnt > 0u ? cnt : 1u;
}

__device__ __forceinline__ void xcd_barrier(const XcdBarrier& b) {
    asm volatile("s_waitcnt vmcnt(0)" ::: "memory");
    __syncthreads();
    if (threadIdx.x == 0) {
        unsigned* bar = b.bar; asm volatile("" : "+s"(bar));
        __builtin_amdgcn_s_waitcnt(0);
        unsigned nloc = b.st[0], nx = b.st[1];
        if (nloc == 0u) { xcd_barrier_complete(bar, b.x, nloc, nx); b.st[0] = nloc; b.st[1] = nx; }
        const unsigned old = xb_add(&bar[XB_XSUB(b.x)], 1u);
        const unsigned gen = old / nloc;
        if (old + 1u == (gen + 1u) * nloc) {
            __builtin_amdgcn_fence(__ATOMIC_RELEASE, "agent");
            asm volatile("s_waitcnt vmcnt(0)" ::: "memory");
            const unsigned og = xb_add(&bar[XB_TOP], 1u);
            const unsigned tg = og / nx;
            if (og + 1u == (tg + 1u) * nx) xb_add(&bar[XB_TOPGEN], 1u);
            else XB_SPIN(xb_ld(&bar[XB_TOPGEN]) == tg, bar);
            __builtin_amdgcn_fence(__ATOMIC_ACQUIRE, "agent");
            xb_add(&bar[XB_XGEN(b.x)], 1u);
            asm volatile("s_waitcnt vmcnt(0)" ::: "memory");
        } else {
            XB_SPIN(xb_ld(&bar[XB_XGEN(b.x)]) == gen, bar);
            __builtin_amdgcn_fence(__ATOMIC_ACQUIRE, "agent");
            asm volatile("s_waitcnt vmcnt(0)" ::: "memory");
        }
    }
    __syncthreads();
}

constexpr int NPHASE = 24;
template <int PHM> __global__ void __launch_bounds__(NTHR, 2) fwd_kernel(Args A_unused) {
    extern __shared__ __attribute__((aligned(16))) unsigned char lds[];
    cg::grid_group grid = cg::this_grid();
    PG8_LAS unsigned char* glds = (PG8_LAS unsigned char*)lds;
    const int G = GRID;
#define FRESH_TID() int tid_f = threadIdx.x; asm volatile("" : "+v"(tid_f)); const int tid = tid_f, lane = tid & 63, wave = tid >> 6, gw = blockIdx.x * NWAVES + wave, NGW = G * NWAVES, gt = blockIdx.x * NTHR + tid, NGT = G * NTHR; (void)lane; (void)gw; (void)NGW; (void)gt; (void)NGT
    KARGS A0 = *ka_fresh();
#define PHASE_LOCALS() KARGS A = *ka_fresh(); unsigned char* ws = A.ws; unsigned char* C = ws + WS_C; const float* mod = (const float*)(ws + WS_MOD); (void)C; (void)mod
    unsigned char* ws0 = A0.ws;
    volatile LAS unsigned* bst = (volatile LAS unsigned*)((LAS unsigned char*)lds + (LDS_BYTES - 64));
    if (threadIdx.x < 2) bst[threadIdx.x] = 0u;
    __syncthreads();
    XcdBarrier xbar = xcd_barrier_post((unsigned*)(ws0 + WS_XBAR), bst);
    const int lo = A0.ph_lo, hi = A0.ph_hi;
#define KIND(k) ((k) < 2 ? (k) : 2 + (((k) - 2) % 11))
#define IN(k) (((PHM >> KIND(k)) & 1) && lo <= (k) && (k) < hi)
#ifdef SEAM_CG
#define SEAM(k) do { if (IN(k) && IN((k) + 1)) grid.sync(); } while (0)
#else
#define SEAM(k) do { if (IN(k) && IN((k) + 1)) { if ((k) == 0) grid.sync(); else xcd_barrier(xbar); } } while (0)
#endif
    if (IN(0)) { KARGS A = *ka_fresh(); for (int rep = 0; rep < NREP(0); ++rep) { ph0(A, lds); if (REPMASK) __syncthreads(); } } SEAM(0);
    if (IN(1)) { KARGS A = *ka_fresh(); rowpass<0>(A, 0, true, 0, 0, nullptr); } SEAM(1);
    for (int l = 0; l < 2; ++l) {
        const int P = 2 + 11 * l;
        if (IN(P + 0)) {
            PHASE_LOCALS();
            pg8::Gemm g{(const bf16*)(ws + WS_B), (const bf16*)(ws + WS_WIN), M, NPROJ, 1024, 2048, 1 << 20, 0};
            pg8::StaticOrder S; S.init(M, NPROJ, G, (int)blockIdx.x);
            EpiProj E; E.ws = ws; E.out = A.out; E.l = l; E.gq_lat = A.in[15] + l * 256; E.gkv_lat = A.in[17] + l * 128; E.gqn = A.in[24] + l * 64; E.gkn = A.in[25] + l * 64;
            for (int rep = 0; rep < NREP(2); ++rep) { pg8::gemm_phase<EpiProj, pg8::StaticOrder, true, true>(glds, g, S, E); if (rep + 1 < 2 && REPMASK) __syncthreads(); }
            FRESH_TID();
            bf16* ckv = (bf16*)(C + C_CKV) + (size_t)M * 128;
            for (int i = gt; i < 1024 * 128; i += NGT) { const int r = i >> 7, c = i & 127, b = r >> 8, s = r & 255; ckv[i] = (bf16)f2bf(A.in[2][((size_t)(b * 2 + l) * 256 + s) * 128 + c]); }
        }
        SEAM(P + 0);
        if (IN(P + 1)) {
            PHASE_LOCALS();
            { int kq = 256; asm volatile("" : "+s"(kq));
              pg8::Gemm g{(const bf16*)(C + C_QL), (const bf16*)(ws + WS_WUQ), M, 512, kq, 256, 1 << 20, 0}; pg8::StaticOrder S; S.init(M, 512, G, (int)blockIdx.x);
              EpiQa E; E.ws = ws; pg8::gemm_phase<EpiQa, pg8::StaticOrder, true, true>(glds, g, S, E); }
        }
        if (IN(P + 2)) {
            __syncthreads();
            PHASE_LOCALS();
            { int kk = 128; asm volatile("" : "+s"(kk));
              pg8::Gemm g{(const bf16*)(C + C_CKV), (const bf16*)(ws + WS_WUKV), MKVP, 512, kk, 128, 1 << 20, 0}; pg8::StaticOrder S; S.init(MKVP, 512, G, (int)blockIdx.x);
              EpiKv E; E.ws = ws; pg8::gemm_phase<EpiKv, pg8::StaticOrder, true, true>(glds, g, S, E); }
            FRESH_TID();
            const float* sskv = (const float*)(ws + WS_SSKV);
            for (int i = gt; i < MCTX * 32; i += NGT) { const int row = i >> 5, c4 = i & 31; const f32x4 s4 = *(const f32x4*)(sskv + row * 4);
                const float rs = 1.f / sqrtf(((s4[0] + s4[1]) + (s4[2] + s4[3])) * (1.f / 128.f) + EPS);
                f32x4* p = (f32x4*)(A.out + O_CKV + ((size_t)((row >> 8) * 2 + l) * 256 + (row & 255)) * 128) + c4; *p = *p * rs; }
        }
        SEAM(P + 2);
        if (IN(P + 3)) {
            PHASE_LOCALS();
            FRESH_TID();
            volatile unsigned* slot = (volatile unsigned*)(lds + LDS_BYTES - 16);
            for (int rep = 0; rep < NREP(5); ++rep) {
            unsigned* ctr = (unsigned*)(ws + WS_CTR) + l + 2 * rep;
            for (;;) {
                __syncthreads();
                if (tid == 0) *slot = atomicAdd(ctr, 1u);
                __syncthreads();
                const unsigned u = (unsigned)__builtin_amdgcn_readfirstlane((int)*slot);
                if (u >= (unsigned)NU_ATT) break;
                if ((REPMASK & 0x20000) && rep == 1 && u < 16) continue;
                attn_dispatch(A, lds, l, (int)u);
            }
            }
        }
        SEAM(P + 3);
        if (IN(P + 4)) {
            PHASE_LOCALS();
            pg8::Gemm g{(const bf16*)(ws + WS_B), (const bf16*)(ws + WS_WIN) + (size_t)NPROJ * 1024, M, NGATE, 1024, 2048, 1 << 20, 0};
            pg8::StaticOrder S; S.init(M, NGATE, G, (int)blockIdx.x);
            EpiAct<0> E; E.O = (bf16*)C; E.ldc = 4096;
            for (int rep = 0; rep < NREP(6); ++rep) { pg8::gemm_phase<EpiAct<0>, pg8::StaticOrder, true, true>(glds, g, S, E); if (rep + 1 < 2 && REPMASK) __syncthreads(); }
        }
        SEAM(P + 4);
        if (IN(P + 5)) {
            PHASE_LOCALS();
            pg8::Gemm g{(const bf16*)(ws + WS_B) + 1024, (const bf16*)(ws + WS_WB), M, 4096, 256, 2048, 4, 512};
            BranchOrder S; S.c = (int)((blockIdx.x & 7) * 32 + (blockIdx.x >> 3));
            EpiMerge E; E.GT = (const bf16*)C; E.MG = (bf16*)(ws + WS_B);
            pg8::gemm_phase<EpiMerge, BranchOrder, true, true>(glds, g, S, E);
        }
        SEAM(P + 5);
        if (IN(P + 6)) {
            PHASE_LOCALS();
            pg8::Gemm g{(const bf16*)(ws + WS_B), (const bf16*)(ws + WS_WO4), M, 1024, 1024, 2048, 1 << 20, 0};
            pg8::StaticOrder S; S.init(M, 1024, G, (int)blockIdx.x);
            EpiRes E; E.xp = (l == 0) ? A.in[0] : A.out + O_Y; E.xs = (l == 0) ? A.in[1] : A.out + O_Y + (size_t)MCTX * 1024; E.gate = mod + (size_t)l * 5 * 6144 + 2048; E.Z = (float*)C;
            for (int rep = 0; rep < NREP(8); ++rep) { pg8::gemm_phase<EpiRes, pg8::StaticOrder, true, true>(glds, g, S, E); if (REPMASK) __syncthreads(); }
        }
        SEAM(P + 6);
        if (IN(P + 7)) { PHASE_LOCALS(); rowpass<1>(A, l, true, l, 3072, (const float*)C); }
        SEAM(P + 7);
        if (IN(P + 8)) {
            PHASE_LOCALS();
            pg8::Gemm g{(const bf16*)(ws + WS_B), (const bf16*)(ws + WS_WUP), M, FF, 1024, 2048, 1 << 20, 0};
            pg8::StaticOrder S; S.init(M, FF, G, (int)blockIdx.x);
            EpiAct<1> E; E.O = (bf16*)C; E.ldc = 4096;
            for (int rep = 0; rep < NREP(10); ++rep) { pg8::gemm_phase<EpiAct<1>, pg8::StaticOrder, true, true>(glds, g, S, E); if (rep + 1 < 2 && REPMASK) __syncthreads(); }
        }
        SEAM(P + 8);
        if (IN(P + 9)) {
            PHASE_LOCALS();
            pg8::Gemm g{(const bf16*)C, (const bf16*)(ws + WS_WDN), M, 1024, 4096, 4096, 1 << 20, 0};
            pg8::StaticOrder S; S.init(M, 1024, G, (int)blockIdx.x);
            EpiRes E; E.xp = A.out + O_Y; E.xs = A.out + O_Y + (size_t)MCTX * 1024; E.gate = mod + (size_t)l * 5 * 6144 + 5120; E.Z = (float*)(ws + WS_B);
            for (int rep = 0; rep < NREP(11); ++rep) { pg8::gemm_phase<EpiRes, pg8::StaticOrder, true, true>(glds, g, S, E); if (rep + 1 < 2 && REPMASK) __syncthreads(); }
        }
        SEAM(P + 9);
        if (IN(P + 10)) {
            PHASE_LOCALS();
            rowpass<2>(A, l, l == 0, 1, 0, (const float*)(ws + WS_B));
            if (l == 0) { __syncthreads(); FRESH_TID(); conv_weights(A, 1, lds, gw, NGW, wave, lane); }
        }
        if (l == 0) SEAM(P + 10);
    }
#undef IN
#undef SEAM
}

extern "C" void kernel_launch(void* const* d_in, const int* in_sizes, int n_in, void* d_out, int out_size, void* d_ws, size_t ws_size, hipStream_t stream) {
    static int grid = 0;
#ifndef SINGLE_LAUNCH
    static const void* kfn[13] = {(const void*)fwd_kernel<1>, (const void*)fwd_kernel<2>, (const void*)fwd_kernel<4>, (const void*)fwd_kernel<8>, (const void*)fwd_kernel<16>, (const void*)fwd_kernel<32>,
                                  (const void*)fwd_kernel<64>, (const void*)fwd_kernel<128>, (const void*)fwd_kernel<256>, (const void*)fwd_kernel<512>, (const void*)fwd_kernel<1024>, (const void*)fwd_kernel<2048>, (const void*)fwd_kernel<4096>};
#endif
    if (grid == 0) {
        if (n_in != 34 || ws_size < 256 * MiB) { fprintf(stderr, "kernel_launch: unexpected n_in %d / ws_size %zu\n", n_in, ws_size); grid = -1; return; }
        int dev = 0, cus = 0, per_cu = 0;
        hipGetDevice(&dev); hipDeviceGetAttribute(&cus, hipDeviceAttributeMultiprocessorCount, dev);
#ifdef SINGLE_LAUNCH
        if (hipFuncSetAttribute((const void*)fwd_kernel<0x1FFF>, hipFuncAttributeMaxDynamicSharedMemorySize, LDS_BYTES) != hipSuccess) { fprintf(stderr, "kernel_launch: hipFuncSetAttribute failed\n"); grid = -1; return; }
        if (hipOccupancyMaxActiveBlocksPerMultiprocessor(&per_cu, (const void*)fwd_kernel<0x1FFF>, NTHR, LDS_BYTES) != hipSuccess || per_cu < 1) { fprintf(stderr, "kernel_launch: occupancy query gives %d\n", per_cu); per_cu = 1; }
#else
        for (int k = 0; k < 13; ++k) if (hipFuncSetAttribute(kfn[k], hipFuncAttributeMaxDynamicSharedMemorySize, LDS_BYTES) != hipSuccess) { fprintf(stderr, "kernel_launch: hipFuncSetAttribute failed\n"); grid = -1; return; }
        (void)per_cu;
#endif
        (void)hipGetLastError();
        grid = GRID; if (cus != GRID) fprintf(stderr, "kernel_launch: built for %d CUs, device has %d\n", GRID, cus);
    }
    if (grid < 0) return;
    if (hipMemsetAsync((char*)d_ws + WS_CTR, 0, 128 * 1024, stream) != hipSuccess) { fprintf(stderr, "kernel_launch: hipMemsetAsync failed\n"); return; }
    Args a{};
    for (int i = 0; i < 34; ++i) a.in[i] = (const float*)d_in[i];
    a.out = (float*)d_out; a.ws = (unsigned char*)d_ws;
#ifdef SINGLE_LAUNCH
    a.ph_lo = 0; a.ph_hi = NPHASE;
    void* args[] = {&a};
    hipError_t e = hipLaunchCooperativeKernel((const void*)fwd_kernel<0x1FFF>, dim3(grid), dim3(NTHR), args, LDS_BYTES, stream);
    if (e != hipSuccess) fprintf(stderr, "cooperative launch failed: %s (grid %d)\n", hipGetErrorString(e), grid);
#else
    for (int p = 0; p < NPHASE; ++p) {
        a.ph_lo = p; a.ph_hi = p + 1;
        void* args[] = {&a};
        const int kind = p < 2 ? p : 2 + (p - 2) % 11;
        hipError_t e = hipLaunchCooperativeKernel(kfn[kind], dim3(grid), dim3(NTHR), args, LDS_BYTES, stream);
        if (e != hipSuccess) { fprintf(stderr, "launch %d failed: %s\n", p, hipGetErrorString(e)); break; }
    }
#endif
}
```

```cpp
#define SINGLE_LAUNCH 1
#include <hip/hip_runtime.h>
#include <hip/hip_cooperative_groups.h>
#include <cstdio>
#include <cstdint>
namespace cg = cooperative_groups;

namespace pg8 {
#define PG8_LAS __attribute__((address_space(3)))
typedef unsigned short bf16_t;
typedef short bf16x8 __attribute__((ext_vector_type(8)));
typedef float f32x4 __attribute__((ext_vector_type(4)));
typedef unsigned u32x4 __attribute__((ext_vector_type(4)));
constexpr int BM = 256, BK = 64, HALF = 128, HTB = HALF * BK * 2  , STAGE_BYTES = 8 * HTB, NXCD = 8, WGM = 8;

__host__ __device__ __forceinline__ int lds_byte(int r, int c) { const int st = (r >> 4) * 2 + (c >> 5), rr = r & 15, cc = c & 31, ob = rr * 64 + cc * 2; return st * 1024 + (ob ^ (((ob >> 9) & 1) << 5)); }
__host__ __device__ __forceinline__ void stage_rc(int b, int& R, int& C) { const int st = b / 1024, sb = b % 1024, swz = sb ^ (((sb >> 9) & 1) << 5); R = (st >> 1) * 16 + swz / 64; C = (st & 1) * 32 + (swz % 64) / 2; }
__host__ __device__ __forceinline__ int perm32(int rho) { const int n = rho >> 4, i = rho & 15; return 8 * (i >> 2) + 4 * n + (i & 3); }


struct Unit { int pm, pn; };
struct Gemm { const bf16_t* A; const bf16_t* Bt; int M, N, K; int lda; int agt; size_t ago; };
__device__ __forceinline__ const char* uni_ptr(const char* p) { const unsigned long long v = (unsigned long long)p; const unsigned lo = __builtin_amdgcn_readfirstlane((unsigned)v), hi = __builtin_amdgcn_readfirstlane((unsigned)(v >> 32)); return (const char*)(((unsigned long long)hi << 32) | lo); }

struct StaticOrder {
    int nM, nN, nwg, G, c;
    __host__ __device__ void init(int M, int N, int G_, int c_) { nM = M / BM; nN = N / BM; nwg = nM * nN; G = G_; c = c_; }
    __host__ __device__ bool next(int i, Unit& u) const {
        const long L = (long)i * G + c; if (L >= nwg) return false;
        int wgid = (int)L; { const int q = nwg / NXCD, r = nwg % NXCD, xcd = wgid % NXCD, off = wgid / NXCD; wgid = (xcd < r ? xcd * (q + 1) : r * (q + 1) + (xcd - r) * q) + off; }
        const int nig = WGM * nN, gid = wgid / nig, fm = gid * WGM, gsz = (nM - fm) < WGM ? (nM - fm) : WGM;
        u.pm = fm + ((wgid % nig) % gsz); u.pn = (wgid % nig) / gsz; return true;
    }
    __device__ __forceinline__ void a_ready(const Unit&) const {}
    __device__ __forceinline__ void done(const Unit&) const {}
};
__device__ __forceinline__ unsigned cvt_pk_bf16(float lo, float hi) { unsigned r; asm volatile("v_cvt_pk_bf16_f32 %0, %1, %2" : "=v"(r) : "v"(lo), "v"(hi)); return r; }
template <class Epi, class Sched, bool ALIGN_EPI = false, bool SP2 = false>
__device__ __forceinline__ void gemm_phase(PG8_LAS unsigned char* lds, const Gemm g, const Sched& S, const Epi& E) {
    int tid_l = threadIdx.x; asm volatile("" : "+v"(tid_l)); const int tid = tid_l, wid = __builtin_amdgcn_readfirstlane(tid >> 6), lane = tid & 63, wr = wid >> 2, wc = wid & 3, fr = lane & 15, fq = lane >> 4;
    const int K = g.K, nt = K / BK;
    unsigned voffA[2], voffB[2];
#pragma unroll
    for (int i = 0; i < 2; ++i) { int R, C; stage_rc(tid * 16 + i * 8192, R, C); const int Rb = Epi::PERM ? ((R & ~31) + perm32(R & 31)) : R;
        voffA[i] = (unsigned)(R * g.lda + C) * 2u; voffB[i] = (unsigned)(Rb * K + C) * 2u; }
    const size_t kstep = (size_t)(BK * 2);
    const size_t hstepB = (size_t)HALF * K * 2, hstepA = (size_t)HALF * g.lda * 2;
    const size_t tstepB = 2 * hstepB, tstepA = 2 * hstepA;
    const unsigned ldsw = (unsigned)wid * 1024u;
    const int aoff = lds_byte(wr * 64 + fr, fq * 8), boff = lds_byte(wc * 32 + fr, fq * 8);
#define PG8_SA(b, h) (((b) * 2 + (h)) * HTB)
#define PG8_SB(b, h) ((4 + (b) * 2 + (h)) * HTB)
#define PG8_STAGE(bufoff, gbase, voff) do { _Pragma("unroll") for (int _i = 0; _i < 2; ++_i) \
        __builtin_amdgcn_global_load_lds((const unsigned*)(uni_ptr((const char*)(gbase)) + (voff)[_i]), (PG8_LAS unsigned*)(lds + (bufoff) + ldsw + _i * 8192), 16, 0, 0); } while (0)
#define PG8_LDA(dst, b, h) do { _Pragma("unroll") for (int m = 0; m < 4; ++m) _Pragma("unroll") for (int k = 0; k < 2; ++k) dst[m][k] = *(const PG8_LAS bf16x8*)(lds + PG8_SA(b, h) + aoff + m * 2048 + k * 1024); } while (0)
#define PG8_LDB(dst, b, h) do { _Pragma("unroll") for (int n = 0; n < 2; ++n) _Pragma("unroll") for (int k = 0; k < 2; ++k) dst[n][k] = *(const PG8_LAS bf16x8*)(lds + PG8_SB(b, h) + boff + n * 2048 + k * 1024); } while (0)
#define PG8_MMA(ai, bj, At, Bt) do { __builtin_amdgcn_s_setprio(1); _Pragma("unroll") for (int m = 0; m < 4; ++m) _Pragma("unroll") for (int n = 0; n < 2; ++n) _Pragma("unroll") for (int k = 0; k < 2; ++k) \
        acc[ai][bj][m][n] = __builtin_amdgcn_mfma_f32_16x16x32_bf16(Bt[n][k], At[m][k], acc[ai][bj][m][n], 0, 0, 0); __builtin_amdgcn_s_setprio(0); } while (0)
#define PG8_WAIT_V(n) asm volatile("s_waitcnt vmcnt(" #n ")" ::: "memory")
#define PG8_WAIT_L(n) asm volatile("s_waitcnt lgkmcnt(" #n ")" ::: "memory")
#define PG8_BAR __builtin_amdgcn_s_barrier()
#define PG8_SCHED __builtin_amdgcn_sched_barrier(0)
    Unit cur, nxt; int ui = 0;
    if (!S.next(0, cur)) return;
    f32x4 acc[2][2][4][2];
#pragma unroll
    for (int a = 0; a < 2; ++a)
#pragma unroll
        for (int b = 0; b < 2; ++b)
#pragma unroll
            for (int m = 0; m < 4; ++m)
#pragma unroll
                for (int n = 0; n < 2; ++n) acc[a][b][m][n] = (f32x4){0.f, 0.f, 0.f, 0.f};
    bf16x8 At[4][2], B0[2][2], B1[2][2];
    const char* cA = (const char*)g.A + (size_t)cur.pm * tstepA + (size_t)(cur.pn / g.agt) * g.ago; const char* cB = (const char*)g.Bt + (size_t)cur.pn * tstepB;
    S.a_ready(cur);
    if constexpr (SP2) {
        PG8_STAGE(PG8_SB(0, 0), cB, voffB); PG8_STAGE(PG8_SB(0, 1), cB + hstepB, voffB); PG8_STAGE(PG8_SA(0, 0), cA, voffA); PG8_STAGE(PG8_SA(0, 1), cA + hstepA, voffA);
        if (wr == 1) PG8_BAR;
        PG8_WAIT_V(2); PG8_BAR;
        PG8_STAGE(PG8_SB(1, 0), cB + kstep, voffB); PG8_STAGE(PG8_SA(1, 0), cA + kstep, voffA); PG8_STAGE(PG8_SB(1, 1), cB + hstepB + kstep, voffB);
        PG8_WAIT_V(6); PG8_BAR;
    } else {
        PG8_STAGE(PG8_SB(0, 0), cB, voffB); PG8_STAGE(PG8_SA(0, 0), cA, voffA); PG8_STAGE(PG8_SB(0, 1), cB + hstepB, voffB); PG8_STAGE(PG8_SA(0, 1), cA + hstepA, voffA);
        if (wr == 1) PG8_BAR;
        PG8_WAIT_V(4); PG8_BAR;
        PG8_STAGE(PG8_SB(1, 0), cB + kstep, voffB); PG8_STAGE(PG8_SA(1, 0), cA + kstep, voffA); PG8_STAGE(PG8_SB(1, 1), cB + hstepB + kstep, voffB);
        PG8_WAIT_V(6); PG8_BAR;
    }
    for (;;) {
        const bool has_next = S.next(ui + 1, nxt);
        const char* nA = has_next ? (const char*)g.A + (size_t)nxt.pm * tstepA + (size_t)(nxt.pn / g.agt) * g.ago : cA; const char* nB = has_next ? (const char*)g.Bt + (size_t)nxt.pn * tstepB : cB;
        for (int t = 0; t < nt; t += 2) {
            const bool last = (t == nt - 2);
            const char* a1 = cA + (size_t)(t + 1) * kstep;
            const char* a2 = last ? nA : cA + (size_t)(t + 2) * kstep; const char* b2 = last ? nB : cB + (size_t)(t + 2) * kstep;
            const char* a3 = a2 + kstep; const char* b3 = b2 + kstep;
            if (last && has_next) S.a_ready(nxt);
            if constexpr (SP2) {
            PG8_LDB(B0, 0, 0); PG8_LDB(B1, 0, 1); PG8_SCHED; PG8_LDA(At, 0, 0); PG8_STAGE(PG8_SA(1, 1), a1 + hstepA, voffA);
            PG8_WAIT_V(8); PG8_WAIT_L(0); PG8_BAR; PG8_MMA(0, 0, At, B0); PG8_MMA(0, 1, At, B1); PG8_BAR; PG8_SCHED;
            PG8_LDA(At, 0, 1); PG8_STAGE(PG8_SB(0, 0), b2, voffB); PG8_STAGE(PG8_SB(0, 1), b2 + hstepB, voffB); PG8_STAGE(PG8_SA(0, 0), a2, voffA);
            PG8_WAIT_V(8); PG8_WAIT_L(0); PG8_BAR; PG8_MMA(1, 0, At, B0); PG8_MMA(1, 1, At, B1); PG8_BAR; PG8_SCHED;
            PG8_LDB(B0, 1, 0); PG8_LDB(B1, 1, 1); PG8_SCHED; PG8_LDA(At, 1, 0); PG8_STAGE(PG8_SA(0, 1), a2 + hstepA, voffA);
            PG8_WAIT_V(8); PG8_WAIT_L(0); PG8_BAR; PG8_MMA(0, 0, At, B0); PG8_MMA(0, 1, At, B1); PG8_BAR; PG8_SCHED;
            PG8_LDA(At, 1, 1); PG8_STAGE(PG8_SB(1, 0), b3, voffB); PG8_STAGE(PG8_SB(1, 1), b3 + hstepB, voffB); PG8_STAGE(PG8_SA(1, 0), a3, voffA);
            PG8_WAIT_V(8); PG8_WAIT_L(0); PG8_BAR; PG8_MMA(1, 0, At, B0); PG8_MMA(1, 1, At, B1); PG8_BAR; PG8_SCHED;
            } else {
            PG8_LDB(B0, 0, 0); PG8_SCHED; PG8_LDA(At, 0, 0); PG8_STAGE(PG8_SA(1, 1), a1 + hstepA, voffA);
            PG8_WAIT_L(8); PG8_BAR; PG8_WAIT_L(0); PG8_MMA(0, 0, At, B0); PG8_BAR; PG8_SCHED;
            PG8_LDB(B1, 0, 1); PG8_STAGE(PG8_SB(0, 0), b2, voffB);
            PG8_BAR; PG8_WAIT_L(0); PG8_MMA(0, 1, At, B1); PG8_BAR;
            PG8_LDA(At, 0, 1); PG8_STAGE(PG8_SA(0, 0), a2, voffA);
            PG8_BAR; PG8_WAIT_L(0); PG8_MMA(1, 0, At, B0); PG8_BAR; PG8_SCHED;
            PG8_STAGE(PG8_SB(0, 1), b2 + hstepB, voffB);
            PG8_WAIT_V(6); PG8_BAR; PG8_MMA(1, 1, At, B1); PG8_BAR;
            PG8_LDB(B0, 1, 0); PG8_SCHED; PG8_LDA(At, 1, 0); PG8_STAGE(PG8_SA(0, 1), a2 + hstepA, voffA);
            PG8_WAIT_L(8); PG8_BAR; PG8_WAIT_L(0); PG8_MMA(0, 0, At, B0); PG8_BAR; PG8_SCHED;
            PG8_LDB(B1, 1, 1); PG8_STAGE(PG8_SB(1, 0), b3, voffB);
            PG8_BAR; PG8_WAIT_L(0); PG8_MMA(0, 1, At, B1); PG8_BAR;
            PG8_LDA(At, 1, 1); PG8_STAGE(PG8_SA(1, 0), a3, voffA);
            PG8_BAR; PG8_WAIT_L(0); PG8_MMA(1, 0, At, B0); PG8_BAR; PG8_SCHED;
            PG8_STAGE(PG8_SB(1, 1), b3 + hstepB, voffB);
            PG8_WAIT_V(6); PG8_BAR; PG8_MMA(1, 1, At, B1); PG8_BAR;
            }
        }
        if constexpr (ALIGN_EPI) { if (wr == 0) PG8_BAR; }
        if constexpr (!Epi::AFTER_DRAIN) { E(acc, cur, wr, wc, fr, fq); S.done(cur); }
        if (!has_next) break;
#pragma unroll
        for (int a = 0; a < 2; ++a)
#pragma unroll
            for (int b = 0; b < 2; ++b)
#pragma unroll
                for (int m = 0; m < 4; ++m)
#pragma unroll
                    for (int n = 0; n < 2; ++n) acc[a][b][m][n] = (f32x4){0.f, 0.f, 0.f, 0.f};
        cur = nxt; cA = nA; cB = nB; ++ui;
        if constexpr (ALIGN_EPI) { if (wr == 1) PG8_BAR; }
    }
    PG8_WAIT_V(0);
    if constexpr (!ALIGN_EPI) { if (wr == 0) PG8_BAR; }
    PG8_BAR;
    if constexpr (Epi::AFTER_DRAIN) { E.fused(acc, cur, wr, wc, fr, fq, lds, wid, lane); S.done(cur); }
#undef PG8_SA
#undef PG8_SB
#undef PG8_STAGE
#undef PG8_LDA
#undef PG8_LDB
#undef PG8_MMA
#undef PG8_WAIT_V
#undef PG8_WAIT_L
#undef PG8_BAR
#undef PG8_SCHED
}
}

#define LAS __attribute__((address_space(3)))
typedef unsigned short bf16;
typedef short bf16x8 __attribute__((ext_vector_type(8)));
typedef float f32x4 __attribute__((ext_vector_type(4)));
typedef unsigned u32x4 __attribute__((ext_vector_type(4)));
typedef unsigned u32x2 __attribute__((ext_vector_type(2)));

constexpr int NTHR = 512, NWAVES = 8, GRID = 256;
constexpr int M = 16384, MCTX = 8192, D = 1024, FF = 4096;
constexpr int IN_DIM = 6560, NPROJ = 2560, NGATE = 4096, NIN = NPROJ + NGATE;
constexpr int MKV = 17408;
constexpr int MKVP = 18432;
constexpr float EPS = 1e-6f, ALPHA = 1.4142135623730951f, MLA_SCALE = 0.10206207261596575f * 1.4426950408889634f  , LOG2_BASE = 13.287712379549449f;
constexpr int LDS_BYTES = 149504;
constexpr int LDS_TSCR = 131072;

#ifndef REPMASK
#define REPMASK 0
#endif
#define NREP(kind) (((REPMASK >> (kind)) & 1) ? 2 : 1)
constexpr size_t MiB = 1u << 20;
constexpr size_t WS_MOD = 0;
constexpr size_t WS_SSQ = 256 * 1024, WS_SSKV = 512 * 1024;
constexpr size_t WS_CTR = 768 * 1024;
constexpr size_t WS_XBAR = 832 * 1024;
constexpr size_t WS_CACHE = 1 * MiB, CACHE_L = 1280 * 1024;
constexpr size_t CA_KPE = 0, CA_WK = 64 * 1024, CA_WV = 320 * 1024, CA_GK = 576 * 1024, CA_GV = 832 * 1024;
constexpr size_t WS_WIN = 4 * MiB, WS_WUQ = 17 * MiB, WS_WUKV = 17 * MiB + 256 * 1024, WS_WB = 18 * MiB, WS_WO4 = 20 * MiB, WS_WUP = 28 * MiB, WS_WDN = 36 * MiB;
constexpr size_t WS_B = 44 * MiB;
constexpr size_t WS_C = 108 * MiB;
constexpr size_t C_QL = 0, C_RQ = 8 * MiB, C_RK = 16 * MiB, C_RV = 24 * MiB, C_RG = 32 * MiB, C_WQ = 40 * MiB, C_WKV = 48 * MiB, C_GQ = 56 * MiB, C_GKV = 64 * MiB;
constexpr size_t C_CKV = 72 * MiB, C_KPE = 77 * MiB, C_QA = 78 * MiB, C_KN = 90 * MiB, C_VA = 99 * MiB;
constexpr size_t C_RVT = C_RV, C_MVT = C_VA, C_RKT = 108 * MiB, C_WVT = 116 * MiB, C_GVT = 120 * MiB;
static_assert(C_VA + (size_t)MKVP * 256 * 2 <= 128 * MiB && C_KN + (size_t)MKVP * 256 * 2 <= C_VA && C_CKV + (size_t)MKVP * 128 * 2 <= C_KPE, "region C");
constexpr size_t O_Y = 0, O_CKV = 16777216, O_KPE = 18874368, O_WK = 19398656, O_WV = 21495808, O_GK = 23592960, O_GV = 25690112, O_RF = 27787264, O_RB = 28835840;

struct Args { const float* in[34]; float* out; unsigned char* ws; int ph_lo, ph_hi; };
typedef const __attribute__((address_space(4))) Args& KARGS;
__device__ __forceinline__ const __attribute__((address_space(4))) Args* ka_fresh() { const __attribute__((address_space(4))) Args* p = (const __attribute__((address_space(4))) Args*)__builtin_amdgcn_kernarg_segment_ptr(); asm volatile("" : "+s"(p)); return p; }

__device__ __forceinline__ unsigned pk2(float lo, float hi) { unsigned r; asm("v_cvt_pk_bf16_f32 %0, %1, %2" : "=v"(r) : "v"(lo), "v"(hi)); return r; }
__device__ __forceinline__ unsigned f2bf(float f) { return pk2(f, 0.f) & 0xffffu; }
__device__ __forceinline__ float bflo(unsigned u) { return __builtin_bit_cast(float, u << 16); }
__device__ __forceinline__ float bfhi(unsigned u) { return __builtin_bit_cast(float, u & 0xffff0000u); }
__device__ __forceinline__ u32x4 pk8(const f32x4& a, const f32x4& b) { u32x4 w; w.x = pk2(a[0], a[1]); w.y = pk2(a[2], a[3]); w.z = pk2(b[0], b[1]); w.w = pk2(b[2], b[3]); return w; }
__device__ __forceinline__ void st_t8(bf16* T, size_t ld, int col0, int row, const f32x4& v0, const f32x4& v1) {
    bf16* p = T + (size_t)col0 * ld + row;
    const unsigned w0 = pk2(v0[0], v0[1]), w1 = pk2(v0[2], v0[3]), w2 = pk2(v1[0], v1[1]), w3 = pk2(v1[2], v1[3]);
    p[0] = (bf16)w0; p[ld] = (bf16)(w0 >> 16); p[2 * ld] = (bf16)w1; p[3 * ld] = (bf16)(w1 >> 16);
    p[4 * ld] = (bf16)w2; p[5 * ld] = (bf16)(w2 >> 16); p[6 * ld] = (bf16)w3; p[7 * ld] = (bf16)(w3 >> 16);
}
__device__ __forceinline__ void st_tr(unsigned char* lds, int wid, bf16* T, size_t ld, int rowbase, int cbase, int cstride, int fr, int fq, const f32x4& a0, const f32x4& a1, const f32x4& b0, const f32x4& b1) {
    unsigned* scr = (unsigned*)(lds + LDS_TSCR + wid * 2048);
    const bool odd = (fr & 1) != 0;
    const float lo[8] = {a0[0], a0[1], a0[2], a0[3], a1[0], a1[1], a1[2], a1[3]}, hi[8] = {b0[0], b0[1], b0[2], b0[3], b1[0], b1[1], b1[2], b1[3]};
    unsigned* wp = scr + ((odd ? 32 : 0) + fq * 8) * 8 + (fr >> 1);
#pragma unroll
    for (int e = 0; e < 8; ++e) {
        const float send = odd ? lo[e] : hi[e], mine = odd ? hi[e] : lo[e];
        const float recv = __builtin_bit_cast(float, __builtin_amdgcn_update_dpp(0, __builtin_bit_cast(int, send), 0xB1, 0xF, 0xF, true));
        wp[e * 8] = odd ? pk2(recv, mine) : pk2(mine, recv);
    }
    asm volatile("" ::: "memory");
    const int lane = fq * 16 + fr;
#pragma unroll
    for (int k = 0; k < 2; ++k) {
        const int q = lane + 64 * k, cidx = q >> 1, half = q & 1;
        const u32x4 v = *(const u32x4*)(scr + cidx * 8 + half * 4);
        *(u32x4*)(T + (size_t)(cbase + cstride * (cidx >> 5) + (cidx & 31)) * ld + rowbase + half * 8) = v;
    }
    asm volatile("" ::: "memory");
}
__device__ __forceinline__ float sigmoidf_(float x) { return 1.f / (1.f + __expf(-x)); }
__device__ __forceinline__ float sin_turns(float t) { return __builtin_amdgcn_sinf(t); }
__device__ __forceinline__ float cos_turns(float t) { return __builtin_amdgcn_cosf(t); }
__device__ __forceinline__ float rope_turns(float p, int j, float inv_nf) { const float a = p * __builtin_amdgcn_exp2f(-(float)j * inv_nf * LOG2_BASE) * 0.15915494309189535f; return a - floorf(a); }


struct EpiBase { static constexpr bool PERM = true, AFTER_DRAIN = false; };

struct EpiProj : EpiBase {
    unsigned char* ws; float* out; int l; unsigned char* lds;
    const float *gq_lat, *gkv_lat, *gqn, *gkn;
    __device__ __forceinline__ void operator()(const f32x4 (&acc)[2][2][4][2], const pg8::Unit& u, int wr, int wc, int fr_, int fq_) const {
        int fr = fr_, fq = fq_; asm volatile("" : "+v"(fr), "+v"(fq));
        unsigned char* C = ws + WS_C;
        const int pn = u.pn;
        const bool isctx = u.pm < (MCTX / 256);
#pragma unroll
        for (int ai = 0; ai < 2; ++ai)
#pragma unroll
            for (int m = 0; m < 4; ++m) {
                const int row = u.pm * 256 + ai * 128 + wr * 64 + m * 16 + fr;
                f32x4 a0 = acc[ai][0][m][0], a1 = acc[ai][0][m][1], b0 = acc[ai][1][m][0], b1 = acc[ai][1][m][1];
                const int c0 = wc * 32 + fq * 8;
                const int tl = isctx ? (row & 255) : ((row - MCTX) & 2047);
                const size_t crow = isctx ? ((size_t)((row >> 8) * 2 + l) * 256 + tl) : 0;
                const float prow = (float)(tl >> 6), pcol = (float)(tl & 63);
                if (pn == 0) {
                    float ss = 0.f;
#pragma unroll
                    for (int e = 0; e < 4; ++e) ss += a0[e] * a0[e] + a1[e] * a1[e] + b0[e] * b0[e] + b1[e] * b1[e];
                    ss += __shfl_xor(ss, 16); ss += __shfl_xor(ss, 32);
                    if (fq == 0) ((float*)(ws + WS_SSQ))[row * 4 + wc] = ss;
                    const f32x4 g0 = *(const f32x4*)(gq_lat + c0), g1 = *(const f32x4*)(gq_lat + c0 + 4), g2 = *(const f32x4*)(gq_lat + 128 + c0), g3 = *(const f32x4*)(gq_lat + 128 + c0 + 4);
                    bf16* dst = (bf16*)(C + C_QL) + (size_t)row * 256;
                    *(u32x4*)(dst + c0) = pk8(a0 * g0, a1 * g1); *(u32x4*)(dst + 128 + c0) = pk8(b0 * g2, b1 * g3);
                } else if (pn == 1) {
                    float ss = 0.f;
#pragma unroll
                    for (int e = 0; e < 4; ++e) ss += a0[e] * a0[e] + a1[e] * a1[e];
                    ss += __shfl_xor(ss, 16); ss += __shfl_xor(ss, 32);
                    if (fq == 0) ((float*)(ws + WS_SSKV))[row * 4 + wc] = ss;
                    const f32x4 g0 = *(const f32x4*)(gkv_lat + c0), g1 = *(const f32x4*)(gkv_lat + c0 + 4);
                    a0 = a0 * g0; a1 = a1 * g1;
                    *(u32x4*)((bf16*)(C + C_CKV) + (size_t)row * 128 + c0) = pk8(a0, a1);
                    if (isctx) { float* o = out + O_CKV + crow * 128 + c0; *(f32x4*)o = a0; *(f32x4*)(o + 4) = a1; }
                    if (wc == 0) {
                        if (isctx) { float* o = out + O_KPE + crow * 32; *(f32x4*)(o + 4 * fq) = b0; *(f32x4*)(o + 16 + 4 * fq) = b1; }
                        else {
                            const float p = fq < 2 ? prow : pcol;
#pragma unroll
                            for (int e = 0; e < 4; ++e) { const float t = rope_turns(p, (4 * fq + e) & 7, 0.125f), cs = cos_turns(t), sn = sin_turns(t); const float x1 = b0[e], x2 = b1[e]; b0[e] = x1 * cs - x2 * sn; b1[e] = x1 * sn + x2 * cs; }
                        }
                        bf16* dst = (bf16*)(C + C_KPE) + (size_t)row * 32;
                        u32x2 w0, w1; w0.x = pk2(b0[0], b0[1]); w0.y = pk2(b0[2], b0[3]); w1.x = pk2(b1[0], b1[1]); w1.y = pk2(b1[2], b1[3]);
                        *(u32x2*)(dst + 4 * fq) = w0; *(u32x2*)(dst + 16 + 4 * fq) = w1;
                    }
                } else if (pn <= 5) {
                    if (pn == 3) { a0 = a0 * 0.125f; a1 = a1 * 0.125f; b0 = b0 * 0.125f; b1 = b1 * 0.125f; }
                    if (pn == 5) {
#pragma unroll
                        for (int e = 0; e < 4; ++e) { a0[e] *= sigmoidf_(a0[e]); a1[e] *= sigmoidf_(a1[e]); b0[e] *= sigmoidf_(b0[e]); b1[e] *= sigmoidf_(b1[e]); }
                    }
                    if (pn != 4) { bf16* dst = (bf16*)(C + C_RQ + (size_t)(pn - 2) * 8 * MiB) + (size_t)row * 256; *(u32x4*)(dst + c0) = pk8(a0, a1); *(u32x4*)(dst + 128 + c0) = pk8(b0, b1); }
                    if (pn == 3 || pn == 4) st_tr(lds, wr * 4 + wc, (bf16*)(C + (pn == 3 ? C_RKT : C_RVT)), M, row - fr, wc * 32, 128, fr, fq, a0, a1, b0, b1);
                } else {
                    const bool qtile = (pn == 6 || pn == 8), normt = (pn >= 8);
                    const bool isv = (!qtile && wc >= 2);
                    if (normt && !isv) {
                        float ss = 0.f;
#pragma unroll
                        for (int e = 0; e < 4; ++e) ss += a0[e] * a0[e] + a1[e] * a1[e] + b0[e] * b0[e] + b1[e] * b1[e];
                        ss += __shfl_xor(ss, 16); ss += __shfl_xor(ss, 32);
                        const float rs = 1.f / sqrtf(ss * (1.f / 64.f) + EPS);
                        const float* gn = qtile ? gqn : gkn;
                        const f32x4 g0 = *(const f32x4*)(gn + 8 * fq), g1 = *(const f32x4*)(gn + 8 * fq + 4), g2 = *(const f32x4*)(gn + 32 + 8 * fq), g3 = *(const f32x4*)(gn + 36 + 8 * fq);
                        a0 = a0 * g0 * rs; a1 = a1 * g1 * rs; b0 = b0 * g2 * rs; b1 = b1 * g3 * rs;
                    }
                    if (isctx && !qtile) {
                        const size_t ob = (pn == 7) ? (isv ? O_WV : O_WK) : (isv ? O_GV : O_GK);
                        float* o = out + ob + crow * 128 + (wc & 1) * 64 + 8 * fq;
                        *(f32x4*)o = a0; *(f32x4*)(o + 4) = a1; *(f32x4*)(o + 32) = b0; *(f32x4*)(o + 36) = b1;
                    }
                    if (!isctx && !isv) {
                        const float p = fq < 2 ? prow : pcol;
#pragma unroll
                        for (int e = 0; e < 4; ++e) {
                            const float t = rope_turns(p, (8 * fq + e) & 15, 0.0625f), cs = cos_turns(t), sn = sin_turns(t);
                            const float x1 = a0[e], x2 = b0[e]; a0[e] = x1 * cs - x2 * sn; b0[e] = x1 * sn + x2 * cs;
                            const float t2 = rope_turns(p, (8 * fq + 4 + e) & 15, 0.0625f), cs2 = cos_turns(t2), sn2 = sin_turns(t2);
                            const float y1 = a1[e], y2 = b1[e]; a1[e] = y1 * cs2 - y2 * sn2; b1[e] = y1 * sn2 + y2 * cs2;
                        }
                    }
                    if (qtile) { constexpr float QS = 0.125f * 1.4426950408889634f; a0 = a0 * QS; a1 = a1 * QS; b0 = b0 * QS; b1 = b1 * QS; }
                    size_t boff; int coff;
                    if (pn == 6) { boff = C_WQ; coff = wc * 64; } else if (pn == 8) { boff = C_GQ; coff = wc * 64; }
                    else { boff = (pn == 7) ? C_WKV : C_GKV; coff = (isv ? 128 : 0) + (wc & 1) * 64; }
                    if (isv) st_tr(lds, wr * 4 + wc, (bf16*)(C + (pn == 7 ? C_WVT : C_GVT)), M, row - fr, (wc & 1) * 64, 32, fr, fq, a0, a1, b0, b1);
                    else { bf16* dst = (bf16*)(C + boff) + (size_t)row * 256 + coff + 8 * fq; *(u32x4*)dst = pk8(a0, a1); *(u32x4*)(dst + 32) = pk8(b0, b1); }
                }
                asm volatile("" ::: "memory"); __builtin_amdgcn_sched_barrier(0);
            }
    }
};

struct EpiQa : EpiBase {
    unsigned char* ws;
    __device__ __forceinline__ void operator()(const f32x4 (&acc)[2][2][4][2], const pg8::Unit& u, int wr, int wc, int fr_, int fq_) const {
        int fr = fr_, fq = fq_; asm volatile("" : "+v"(fr), "+v"(fq));
        bf16* QA = (bf16*)(ws + WS_C + C_QA);
        const float* ssq = (const float*)(ws + WS_SSQ);
        const bool isctx = u.pm < (MCTX / 256);
#pragma unroll
        for (int ai = 0; ai < 2; ++ai)
#pragma unroll
            for (int m = 0; m < 4; ++m) {
                const int row = u.pm * 256 + ai * 128 + wr * 64 + m * 16 + fr;
                const f32x4 s4 = *(const f32x4*)(ssq + row * 4);
                const float rs = MLA_SCALE / sqrtf(((s4[0] + s4[1]) + (s4[2] + s4[3])) * (1.f / 256.f) + EPS);
                f32x4 a0 = acc[ai][0][m][0] * rs, a1 = acc[ai][0][m][1] * rs, b0 = acc[ai][1][m][0] * rs, b1 = acc[ai][1][m][1] * rs;
                bf16* dst = QA + (size_t)row * 384;
                if (u.pn == 0) {
                    const int p0 = wc * 32 + fq * 8, p1 = 128 + p0;
                    *(u32x4*)(dst + (p0 >> 6) * 96 + (p0 & 63)) = pk8(a0, a1);
                    *(u32x4*)(dst + (p1 >> 6) * 96 + (p1 & 63)) = pk8(b0, b1);
                } else {
                    if (!isctx) {
                        const int tl = (row - MCTX) & 2047; const float p = fq < 2 ? (float)(tl >> 6) : (float)(tl & 63);
#pragma unroll
                        for (int e = 0; e < 4; ++e) { const float t = rope_turns(p, (4 * fq + e) & 7, 0.125f), cs = cos_turns(t), sn = sin_turns(t); const float x1 = a0[e], x2 = a1[e]; a0[e] = x1 * cs - x2 * sn; a1[e] = x1 * sn + x2 * cs; }
                    }
                    u32x2 w0, w1; w0.x = pk2(a0[0], a0[1]); w0.y = pk2(a0[2], a0[3]); w1.x = pk2(a1[0], a1[1]); w1.y = pk2(a1[2], a1[3]);
                    *(u32x2*)(dst + wc * 96 + 64 + 4 * fq) = w0; *(u32x2*)(dst + wc * 96 + 80 + 4 * fq) = w1;
                }
                asm volatile("" ::: "memory"); __builtin_amdgcn_sched_barrier(0);
            }
    }
};

struct EpiKv : EpiBase {
    unsigned char* ws; unsigned char* lds;
    __device__ __forceinline__ void operator()(const f32x4 (&acc)[2][2][4][2], const pg8::Unit& u, int wr, int wc, int fr_, int fq_) const {
        int fr = fr_, fq = fq_; asm volatile("" : "+v"(fr), "+v"(fq));
        bf16* O = (bf16*)(ws + WS_C + (u.pn == 0 ? C_KN : C_VA));
        const float* sskv = (const float*)(ws + WS_SSKV);
        const bool tok = u.pm < (M / 256);
#pragma unroll
        for (int ai = 0; ai < 2; ++ai)
#pragma unroll
            for (int m = 0; m < 4; ++m) {
                const int row = u.pm * 256 + ai * 128 + wr * 64 + m * 16 + fr;
                float rs = 1.f;
                if (tok) { const f32x4 s4 = *(const f32x4*)(sskv + row * 4); rs = 1.f / sqrtf(((s4[0] + s4[1]) + (s4[2] + s4[3])) * (1.f / 128.f) + EPS); }
                if (u.pn == 0) { bf16* dst = O + (size_t)row * 256 + wc * 32 + fq * 8;
                    *(u32x4*)dst = pk8(acc[ai][0][m][0] * rs, acc[ai][0][m][1] * rs); *(u32x4*)(dst + 128) = pk8(acc[ai][1][m][0] * rs, acc[ai][1][m][1] * rs); }
                else st_tr(lds, wr * 4 + wc, O, MKVP, row - fr, wc * 32, 128, fr, fq, acc[ai][0][m][0] * rs, acc[ai][0][m][1] * rs, acc[ai][1][m][0] * rs, acc[ai][1][m][1] * rs);
                asm volatile("" ::: "memory"); __builtin_amdgcn_sched_barrier(0);
            }
    }
};

template <int ACT> struct EpiAct : EpiBase {
    bf16* O; int ldc;
    __device__ __forceinline__ void operator()(const f32x4 (&acc)[2][2][4][2], const pg8::Unit& u, int wr, int wc, int fr_, int fq_) const {
        int fr = fr_, fq = fq_; asm volatile("" : "+v"(fr), "+v"(fq));
#pragma unroll
        for (int ai = 0; ai < 2; ++ai)
#pragma unroll
            for (int m = 0; m < 4; ++m) {
                const int row = u.pm * 256 + ai * 128 + wr * 64 + m * 16 + fr;
                bf16* dst = O + (size_t)row * ldc + u.pn * 256 + wc * 32 + fq * 8;
#pragma unroll
                for (int bj = 0; bj < 2; ++bj) {
                    f32x4 v0 = acc[ai][bj][m][0], v1 = acc[ai][bj][m][1];
#pragma unroll
                    for (int e = 0; e < 4; ++e) {
                        if (ACT == 0) { v0[e] = sigmoidf_(v0[e]); v1[e] = sigmoidf_(v1[e]); }
                        else { const float r0 = fmaxf(v0[e], 0.f), r1 = fmaxf(v1[e], 0.f); v0[e] = r0 * r0; v1[e] = r1 * r1; }
                    }
                    *(u32x4*)(dst + bj * 128) = pk8(v0, v1);
                }
                asm volatile("" ::: "memory"); __builtin_amdgcn_sched_barrier(0);
            }
    }
};

struct BranchOrder {
    int c;
    __device__ __forceinline__ bool next(int i, pg8::Unit& u) const { if (i >= 4) return false; u.pm = c >> 2; u.pn = i * 4 + (c & 3); return true; }
    __device__ __forceinline__ void a_ready(const pg8::Unit&) const {}
    __device__ __forceinline__ void done(const pg8::Unit&) const {}
};
struct EpiMerge : EpiBase {
    const bf16* GT; bf16* MG;
    __device__ __forceinline__ void operator()(const f32x4 (&acc)[2][2][4][2], const pg8::Unit& u, int wr, int wc, int fr_, int fq_) const {
        int fr = fr_, fq = fq_; asm volatile("" : "+v"(fr), "+v"(fq));
        const int br = u.pn >> 2, ct = u.pn & 3;
#pragma unroll
        for (int ai = 0; ai < 2; ++ai)
#pragma unroll
            for (int m = 0; m < 4; ++m) {
                const int row = u.pm * 256 + ai * 128 + wr * 64 + m * 16 + fr;
                const bf16* gp = GT + (size_t)row * 4096 + u.pn * 256 + wc * 32 + fq * 8;
                bf16* mp = MG + (size_t)row * 4096 + ct * 256 + wc * 32 + fq * 8;
#pragma unroll
                for (int bj = 0; bj < 2; ++bj) {
                    const u32x4 g = *(const u32x4*)(gp + bj * 128);
                    const f32x4 v0 = acc[ai][bj][m][0], v1 = acc[ai][bj][m][1];
                    float r0 = bflo(g.x) * v0[0], r1 = bfhi(g.x) * v0[1], r2 = bflo(g.y) * v0[2], r3 = bfhi(g.y) * v0[3], r4 = bflo(g.z) * v1[0], r5 = bfhi(g.z) * v1[1], r6 = bflo(g.w) * v1[2], r7 = bfhi(g.w) * v1[3];
                    if (br > 0) { const u32x4 p = *(const u32x4*)(mp + bj * 128); r0 += bflo(p.x); r1 += bfhi(p.x); r2 += bflo(p.y); r3 += bfhi(p.y); r4 += bflo(p.z); r5 += bfhi(p.z); r6 += bflo(p.w); r7 += bfhi(p.w); }
                    u32x4 w; w.x = pk2(r0, r1); w.y = pk2(r2, r3); w.z = pk2(r4, r5); w.w = pk2(r6, r7);
                    *(u32x4*)(mp + bj * 128) = w;
                }
                asm volatile("" ::: "memory"); __builtin_amdgcn_sched_barrier(0);
            }
    }
};

struct EpiRes : EpiBase {
    const float* xp; const float* xs;
    const float* gate;
    float* Z;
    __device__ __forceinline__ void operator()(const f32x4 (&acc)[2][2][4][2], const pg8::Unit& u, int wr, int wc, int fr_, int fq_) const {
        int fr = fr_, fq = fq_; asm volatile("" : "+v"(fr), "+v"(fq));
        const bool isctx = u.pm < (MCTX / 256);
        const int mr = isctx ? 0 : 1 + ((u.pm * 256 - MCTX) >> 11);
        const float* g = gate + (size_t)mr * 6144 + u.pn * 256 + wc * 32 + fq * 8;
        f32x4 gv[2][2];
#pragma unroll
        for (int bj = 0; bj < 2; ++bj) { gv[bj][0] = *(const f32x4*)(g + bj * 128); gv[bj][1] = *(const f32x4*)(g + bj * 128 + 4); }
#pragma unroll
        for (int ai = 0; ai < 2; ++ai)
#pragma unroll
            for (int m = 0; m < 4; ++m) {
                const int row = u.pm * 256 + ai * 128 + wr * 64 + m * 16 + fr;
                const float* x = (isctx ? xp + (size_t)row * 1024 : xs + (size_t)(row - MCTX) * 1024) + u.pn * 256 + wc * 32 + fq * 8;
                float* z = Z + (size_t)row * 1024 + u.pn * 256 + wc * 32 + fq * 8;
#pragma unroll
                for (int bj = 0; bj < 2; ++bj) {
                    const f32x4 x0 = *(const f32x4*)(x + bj * 128), x1 = *(const f32x4*)(x + bj * 128 + 4);
                    *(f32x4*)(z + bj * 128) = x0 * ALPHA + gv[bj][0] * acc[ai][bj][m][0];
                    *(f32x4*)(z + bj * 128 + 4) = x1 * ALPHA + gv[bj][1] * acc[ai][bj][m][1];
                }
                asm volatile("" ::: "memory"); __builtin_amdgcn_sched_barrier(0);
            }
    }
};

__device__ __forceinline__ float wave_sum(float v) {
#pragma unroll
    for (int o = 1; o < 64; o <<= 1) v += __shfl_xor(v, o);
    return v;
}

__device__ __forceinline__ int win_dst_row(int c) {
    if (c < 384) return c;
    if (c < 416) { const int j = c - 384; return 384 + ((j < 16) ? (8 * (j >> 2) + (j & 3)) : (8 * ((j - 16) >> 2) + 4 + (j & 3))); }
    if (c < 1440) return 512 + (c - 416);
    if (c < 2464) {
        int base, slot, i;
        if (c < 1696) { base = 1536; slot = (c - 1440) >> 6; i = (c - 1440) & 63; }
        else if (c < 1824) { base = 1792; slot = (c - 1696) >> 6; i = (c - 1696) & 63; }
        else if (c < 1952) { base = 1792; slot = 2 + ((c - 1824) >> 6); i = (c - 1824) & 63; }
        else if (c < 2208) { base = 2048; slot = (c - 1952) >> 6; i = (c - 1952) & 63; }
        else if (c < 2336) { base = 2304; slot = (c - 2208) >> 6; i = (c - 2208) & 63; }
        else { base = 2304; slot = 2 + ((c - 2336) >> 6); i = (c - 2336) & 63; }
        return base + 128 * (i >> 5) + 32 * slot + (i & 31);
    }
    return 2560 + (c - 2464);
}
__device__ __forceinline__ int wuq_dst_row(int c) {
    const int h = c / 96, i = c - h * 96;
    if (i < 64) return h * 64 + i;
    const int j = i - 64;
    return 256 + 32 * h + ((j < 16) ? (8 * (j >> 2) + (j & 3)) : (8 * ((j - 16) >> 2) + 4 + (j & 3)));
}

template <int MAP> __device__ __forceinline__ void tr_item(const float* W, int N, bf16* WT, int Kd, int row_off, int item, float* scr, int lane, int rep, int repstride) {
    const int nblk = N / 32, kb = item / nblk, nb = item % nblk, k0 = 64 * kb, n0 = 32 * nb;
#pragma unroll 8
    for (int i = 0; i < 32; ++i) { const int kk = 2 * i + (lane >> 5); scr[kk * 33 + (lane & 31)] = W[(size_t)(k0 + kk) * N + n0 + (lane & 31)]; }
    asm volatile("s_waitcnt lgkmcnt(0)" ::: "memory");
    const int c = lane & 7;
#pragma unroll
    for (int j = 0; j < 4; ++j) {
        const int n = (lane >> 3) + 8 * j; const float* s = scr + (8 * c) * 33 + n;
        u32x4 o; o.x = pk2(s[0 * 33], s[1 * 33]); o.y = pk2(s[2 * 33], s[3 * 33]); o.z = pk2(s[4 * 33], s[5 * 33]); o.w = pk2(s[6 * 33], s[7 * 33]);
        const int sc = n0 + n; const int dr = (MAP == 1) ? win_dst_row(sc) : (MAP == 2) ? wuq_dst_row(sc) : sc;
        bf16* d = WT + (size_t)(row_off + dr) * Kd + k0 + 8 * c;
        for (int r = 0; r < rep; ++r) *(u32x4*)(d + r * repstride) = o;
    }
    asm volatile("s_waitcnt lgkmcnt(0)" ::: "memory");
}

__device__ __forceinline__ void conv_weights(KARGS A, int l, unsigned char* lds, int gw, int NGW, int wave, int lane) {
    float* scr = (float*)(lds + 32768 + wave * 8704);
    unsigned char* ws = A.ws;
    constexpr int I_IN = 16 * 205, I_UQ = 4 * 12, I_UK = 2 * 8, I_B = 4 * 32, I_O = 16 * 32, I_UP = 16 * 128, I_DN = 64 * 32;
    constexpr int NIT = I_IN + I_UQ + 2 * I_UK + 4 * I_B + I_O + I_UP + I_DN;
    for (int it = gw; it < NIT; it += NGW) {
        int r = it;
        if (r < I_IN) { tr_item<1>(A.in[14] + (size_t)l * 1024 * IN_DIM, IN_DIM, (bf16*)(ws + WS_WIN), 1024, 0, r, scr, lane, 1, 0); continue; } r -= I_IN;
        if (r < I_UQ) { tr_item<2>(A.in[16] + (size_t)l * 256 * 384, 384, (bf16*)(ws + WS_WUQ), 256, 0, r, scr, lane, 1, 0); continue; } r -= I_UQ;
        if (r < I_UK) { tr_item<0>(A.in[18] + (size_t)l * 128 * 256, 256, (bf16*)(ws + WS_WUKV), 128, 0, r, scr, lane, 1, 0); continue; } r -= I_UK;
        if (r < I_UK) { tr_item<0>(A.in[19] + (size_t)l * 128 * 256, 256, (bf16*)(ws + WS_WUKV), 128, 256, r, scr, lane, 1, 0); continue; } r -= I_UK;
        if (r < 4 * I_B) { const int i = r / I_B; tr_item<0>(A.in[26] + (size_t)(l * 4 + i) * 256 * 1024, 1024, (bf16*)(ws + WS_WB), 256, i * 1024, r % I_B, scr, lane, 1, 0); continue; } r -= 4 * I_B;
        if (r < I_O) { tr_item<0>(A.in[27] + (size_t)l * 1024 * 1024, 1024, (bf16*)(ws + WS_WO4), 1024, 0, r, scr, lane, 1, 0); continue; } r -= I_O;
        if (r < I_UP) { tr_item<0>(A.in[30] + (size_t)l * 1024 * 4096, 4096, (bf16*)(ws + WS_WUP), 1024, 0, r, scr, lane, 1, 0); continue; } r -= I_UP;
        tr_item<0>(A.in[31] + (size_t)l * 4096 * 1024, 1024, (bf16*)(ws + WS_WDN), 4096, 0, r, scr, lane, 1, 0);
    }
}

__device__ __forceinline__ void ph0(KARGS A, unsigned char* lds) {
    int tid_l = threadIdx.x; asm volatile("" : "+v"(tid_l)); const int tid = tid_l, lane = tid & 63, wave = tid >> 6;
    const int G = GRID, gw = blockIdx.x * NWAVES + wave, NGW = G * NWAVES;
    float* mod = (float*)(A.ws + WS_MOD);
    float* sl = (float*)lds; float* red = (float*)(lds + 20480);
    for (int i = tid; i < 5 * 1024; i += NTHR) { const int r = i >> 10, k = i & 1023; const float v = (r == 0) ? A.in[11][k] : A.in[10][(r - 1) * 1024 + k]; sl[i] = v / (1.f + __expf(-v)); }
    __syncthreads();
    for (int item = blockIdx.x; item < 192; item += G) {
        const int l = item / 96, cgp = item % 96, col = cgp * 64 + lane;
        const float* W = A.in[12] + ((size_t)l * 1024 + 128 * wave) * 6144 + col;
        float a0 = 0.f, a1 = 0.f, a2 = 0.f, a3 = 0.f, a4 = 0.f;
#pragma unroll 8
        for (int kk = 0; kk < 128; ++kk) { const float w = W[(size_t)kk * 6144]; const int k = 128 * wave + kk; a0 += sl[k] * w; a1 += sl[1024 + k] * w; a2 += sl[2048 + k] * w; a3 += sl[3072 + k] * w; a4 += sl[4096 + k] * w; }
        red[(wave * 5 + 0) * 64 + lane] = a0; red[(wave * 5 + 1) * 64 + lane] = a1; red[(wave * 5 + 2) * 64 + lane] = a2; red[(wave * 5 + 3) * 64 + lane] = a3; red[(wave * 5 + 4) * 64 + lane] = a4;
        __syncthreads();
        if (tid < 320) { const int r = tid >> 6; float s = 0.f;
#pragma unroll
            for (int w = 0; w < 8; ++w) s += red[(w * 5 + r) * 64 + lane];
            mod[((size_t)l * 5 + r) * 6144 + cgp * 64 + lane] = s + A.in[13][l * 6144 + cgp * 64 + lane]; }
        __syncthreads();
    }
    conv_weights(A, 0, lds, gw, NGW, wave, lane);
    const int gt = blockIdx.x * NTHR + tid, NGT = G * NTHR;
    for (int l = 0; l < 2; ++l) {
        unsigned char* cb = A.ws + WS_CACHE + (size_t)l * CACHE_L;
        for (int i = gt; i < 1024 * 32; i += NGT) { const int r = i >> 5, c = i & 31, b = r >> 8, s = r & 255; ((bf16*)(cb + CA_KPE))[i] = (bf16)f2bf(A.in[3][((size_t)(b * 2 + l) * 256 + s) * 32 + c]); }
        for (int i = gt; i < 1024 * 128; i += NGT) { const int r = i >> 7, c = i & 127, b = r >> 8, s = r & 255; const size_t si = ((size_t)(b * 2 + l) * 256 + s) * 128 + c;
            ((bf16*)(cb + CA_WK))[i] = (bf16)f2bf(A.in[4][si]); ((bf16*)(cb + CA_GK))[i] = (bf16)f2bf(A.in[6][si]);
            ((bf16*)(cb + CA_WV))[c * 1024 + r] = (bf16)f2bf(A.in[5][si]); ((bf16*)(cb + CA_GV))[c * 1024 + r] = (bf16)f2bf(A.in[7][si]); }
    }
    if (blockIdx.x == 0 && tid < 64) ((unsigned*)(A.ws + WS_CTR))[tid] = 0u;
}

template <int MODE> __device__ __forceinline__ void rowpass(KARGS A, int l, bool do_mod, int modl, int mod_sh_off, const float* zsrc) {
    int tid_l = threadIdx.x; asm volatile("" : "+v"(tid_l)); const int tid = tid_l, lane = tid & 63, wave = __builtin_amdgcn_readfirstlane(tid >> 6);
    const int gw = blockIdx.x * NWAVES + wave, NGW = GRID * NWAVES;
    const float* mod = (const float*)(A.ws + WS_MOD);
    const float* lg = (MODE == 1) ? A.in[28] + l * 1024 : A.in[32] + l * 1024;
    const float* lb = (MODE == 1) ? A.in[29] + l * 1024 : A.in[33] + l * 1024;
    f32x4 gg[4], bb[4];
#pragma unroll
    for (int j = 0; j < 4; ++j) { gg[j] = (MODE != 0) ? *((const f32x4*)lg + lane + 64 * j) : (f32x4){1.f, 1.f, 1.f, 1.f}; bb[j] = (MODE != 0) ? *((const f32x4*)lb + lane + 64 * j) : (f32x4){0.f, 0.f, 0.f, 0.f}; }
    f32x4 nx[4];
    {
        const int m = gw; const float* src = (MODE == 0) ? ((m < MCTX) ? A.in[0] + (size_t)m * 1024 : A.in[1] + (size_t)(m - MCTX) * 1024) : zsrc + (size_t)m * 1024;
#pragma unroll
        for (int j = 0; j < 4; ++j) nx[j] = *((const f32x4*)src + lane + 64 * j);
    }
    for (int m = gw; m < M; m += NGW) {
        f32x4 v[4];
#pragma unroll
        for (int j = 0; j < 4; ++j) v[j] = nx[j];
        const int mn = m + NGW;
        if (mn < M) {
            const float* src = (MODE == 0) ? ((mn < MCTX) ? A.in[0] + (size_t)mn * 1024 : A.in[1] + (size_t)(mn - MCTX) * 1024) : zsrc + (size_t)mn * 1024;
#pragma unroll
            for (int j = 0; j < 4; ++j) nx[j] = *((const f32x4*)src + lane + 64 * j);
        }
        f32x4 sa[4], sc4[4];
        if (do_mod) {
            const int mr = (m < MCTX) ? 0 : 1 + ((m - MCTX) >> 11);
            const float* sh = mod + ((size_t)modl * 5 + mr) * 6144 + mod_sh_off; const float* sc = sh + 1024;
#pragma unroll
            for (int j = 0; j < 4; ++j) { sa[j] = *((const f32x4*)sh + lane + 64 * j); sc4[j] = *((const f32x4*)sc + lane + 64 * j); }
        }
        if (MODE != 0) {
            float s = 0.f;
#pragma unroll
            for (int j = 0; j < 4; ++j) s += (v[j][0] + v[j][1]) + (v[j][2] + v[j][3]);
            const float mean = wave_sum(s) * (1.f / 1024.f); float s2 = 0.f;
#pragma unroll
            for (int j = 0; j < 4; ++j) { v[j] = v[j] - mean; s2 += (v[j][0] * v[j][0] + v[j][1] * v[j][1]) + (v[j][2] * v[j][2] + v[j][3] * v[j][3]); }
            const float rstd = 1.f / sqrtf(wave_sum(s2) * (1.f / 1024.f) + EPS);
            float* yo = A.out + O_Y + (size_t)m * 1024;
#pragma unroll
            for (int j = 0; j < 4; ++j) { v[j] = v[j] * rstd * gg[j] + bb[j]; *((f32x4*)yo + lane + 64 * j) = v[j]; }
        }
        if (do_mod) {
            bf16* ho = (bf16*)(A.ws + WS_B + (size_t)m * 4096);
#pragma unroll
            for (int j = 0; j < 4; ++j) { const f32x4 h = v[j] * (sc4[j] + 1.f) + sa[j];
                u32x2 w; w.x = pk2(h[0], h[1]); w.y = pk2(h[2], h[3]); *((u32x2*)ho + lane + 64 * j) = w; }
        }
    }
}

struct ASeg { const bf16* k1; const bf16* k2; const bf16* v; int k1s, k2s, vs, nt; };
#define MFMA16(a, b, c) __builtin_amdgcn_mfma_f32_16x16x32_bf16((a), (b), (c), 0, 0, 0)

template <int DQ> __device__ __forceinline__ void attn_unit(unsigned char* lds, const bf16* q, int qs, const ASeg s0, const ASeg s1, const int band, int qpos0, int kpos0, float m0, float l0, bf16* o, int os) {
    constexpr int KSTR = DQ + 8, NKS = DQ / 32, VSTR = 72;
    int tid_l = threadIdx.x; asm volatile("" : "+v"(tid_l)); const int tid = tid_l, lane = tid & 63, w = __builtin_amdgcn_readfirstlane(tid >> 6), i = lane & 15, fq = lane >> 4;
    bf16* Kl = (bf16*)lds; bf16* Vl = (bf16*)(lds + 16384);
    bf16x8 qf[2][NKS];
#pragma unroll
    for (int g = 0; g < 2; ++g)
#pragma unroll
        for (int ks = 0; ks < NKS; ++ks) qf[g][ks] = *(const bf16x8*)(q + (size_t)(32 * w + 16 * g + i) * qs + 32 * ks + 8 * fq);
    f32x4 oacc[2][4];
#pragma unroll
    for (int g = 0; g < 2; ++g)
#pragma unroll
        for (int t = 0; t < 4; ++t) oacc[g][t] = (f32x4){0.f, 0.f, 0.f, 0.f};
    float mrun[2] = {m0, m0}, lrun[2]; lrun[0] = (fq == 0) ? l0 : 0.f; lrun[1] = lrun[0];
    const int ntot = s0.nt + s1.nt;
    const int skey = tid >> 3, sc8 = tid & 7, skey2 = tid >> 2, sc4 = tid & 3;
    u32x4 rk1, rk2 = (u32x4){0u, 0u, 0u, 0u}, rv;
    {
        const ASeg& sg = (s0.nt > 0) ? s0 : s1;
        rk1 = *(const u32x4*)(sg.k1 + (size_t)skey * sg.k1s + 8 * sc8); rv = *(const u32x4*)(sg.v + (size_t)skey * sg.vs + 8 * sc8);
        if (DQ == 96 && tid < 256) rk2 = *(const u32x4*)(sg.k2 + (size_t)skey2 * sg.k2s + 8 * sc4);
    }
    const int qpos = qpos0 + 32 * w + i;
    for (int tt = 0; tt < ntot; ++tt) {
        __syncthreads();
        *(u32x4*)(Kl + skey * KSTR + 8 * sc8) = rk1;
        if (DQ == 96 && tid < 256) *(u32x4*)(Kl + skey2 * KSTR + 64 + 8 * sc4) = rk2;
        *(u32x4*)(Vl + skey * VSTR + 8 * sc8) = rv;
        __syncthreads();
        if (tt + 1 < ntot) {
            const bool in0 = (tt + 1) < s0.nt; const ASeg& sg = in0 ? s0 : s1; const int tl = in0 ? (tt + 1) : (tt + 1 - s0.nt);
            rk1 = *(const u32x4*)(sg.k1 + (size_t)(tl * 64 + skey) * sg.k1s + 8 * sc8); rv = *(const u32x4*)(sg.v + (size_t)skey * sg.vs + tl * 64 + 8 * sc8);
            if (DQ == 96 && tid < 256) rk2 = *(const u32x4*)(sg.k2 + (size_t)(tl * 64 + skey2) * sg.k2s + 8 * sc4);
        }
        f32x4 s[2][4];
#pragma unroll
        for (int jt = 0; jt < 4; ++jt) {
            s[0][jt] = (f32x4){0.f, 0.f, 0.f, 0.f}; s[1][jt] = s[0][jt];
#pragma unroll
            for (int ks = 0; ks < NKS; ++ks) { const bf16x8 kf = *(const bf16x8*)(Kl + (16 * jt + i) * KSTR + 32 * ks + 8 * fq); s[0][jt] = MFMA16(kf, qf[0][ks], s[0][jt]); s[1][jt] = MFMA16(kf, qf[1][ks], s[1][jt]); }
        }
        const bool domask = band && tt < s0.nt;
        bf16x8 pb[2][2];
#pragma unroll
        for (int g = 0; g < 2; ++g) {
            if (domask) {
                const int kb = kpos0 + 64 * tt + 4 * fq, qp = qpos + 16 * g;
#pragma unroll
                for (int jt = 0; jt < 4; ++jt)
#pragma unroll
                    for (int r = 0; r < 4; ++r) { const int dd = qp - (kb + 16 * jt + r); if (dd > 128 || dd < -128) s[g][jt][r] = -1e30f; }
            }
            float mx = -1e30f;
#pragma unroll
            for (int jt = 0; jt < 4; ++jt) mx = fmaxf(mx, fmaxf(fmaxf(s[g][jt][0], s[g][jt][1]), fmaxf(s[g][jt][2], s[g][jt][3])));
            mx = fmaxf(mx, __shfl_xor(mx, 16)); mx = fmaxf(mx, __shfl_xor(mx, 32));
            const float mnew = fmaxf(mrun[g], mx), alpha = __builtin_amdgcn_exp2f(mrun[g] - mnew);
            mrun[g] = mnew;
            float ps = 0.f;
            if (band) {
#pragma unroll
                for (int jt = 0; jt < 4; ++jt)
#pragma unroll
                    for (int r = 0; r < 4; ++r) { const float p = (s[g][jt][r] < -1e29f) ? 0.f : __builtin_amdgcn_exp2f(s[g][jt][r] - mnew); s[g][jt][r] = p; ps += p; }
            } else {
#pragma unroll
                for (int jt = 0; jt < 4; ++jt)
#pragma unroll
                    for (int r = 0; r < 4; ++r) { const float p = __builtin_amdgcn_exp2f(s[g][jt][r] - mnew); s[g][jt][r] = p; ps += p; }
            }
            lrun[g] = lrun[g] * alpha + ps;
#pragma unroll
            for (int t = 0; t < 4; ++t) oacc[g][t] = oacc[g][t] * alpha;
#pragma unroll
            for (int k2 = 0; k2 < 2; ++k2) {
                u32x4 pw; pw.x = pk2(s[g][2 * k2][0], s[g][2 * k2][1]); pw.y = pk2(s[g][2 * k2][2], s[g][2 * k2][3]); pw.z = pk2(s[g][2 * k2 + 1][0], s[g][2 * k2 + 1][1]); pw.w = pk2(s[g][2 * k2 + 1][2], s[g][2 * k2 + 1][3]);
                pb[g][k2] = __builtin_bit_cast(bf16x8, pw);
            }
        }
#pragma unroll
        for (int k2 = 0; k2 < 2; ++k2)
#pragma unroll
            for (int t = 0; t < 4; ++t) {
                const bf16* vp = Vl + (16 * t + i) * VSTR + 32 * k2 + 4 * fq;
                const u32x2 va = *(const u32x2*)vp, vb = *(const u32x2*)(vp + 16);
                u32x4 vw; vw.x = va.x; vw.y = va.y; vw.z = vb.x; vw.w = vb.y;
                const bf16x8 vf = __builtin_bit_cast(bf16x8, vw);
                oacc[0][t] = MFMA16(vf, pb[0][k2], oacc[0][t]); oacc[1][t] = MFMA16(vf, pb[1][k2], oacc[1][t]);
            }
    }
#pragma unroll
    for (int g = 0; g < 2; ++g) {
        float lt = lrun[g]; lt += __shfl_xor(lt, 16); lt += __shfl_xor(lt, 32);
        const float inv = 1.f / lt;
        bf16* od = o + (size_t)(32 * w + 16 * g + i) * os + 4 * fq;
#pragma unroll
        for (int t = 0; t < 4; ++t) { u32x2 wv; wv.x = pk2(oacc[g][t][0] * inv, oacc[g][t][1] * inv); wv.y = pk2(oacc[g][t][2] * inv, oacc[g][t][3] * inv); *(u32x2*)(od + 16 * t) = wv; }
    }
}

__device__ __forceinline__ void ret_unit(KARGS A, unsigned char* lds, int l, bool isctx, int b, int h) {
    constexpr int KS = 72, TS = 136;
    int tid_l = threadIdx.x; asm volatile("" : "+v"(tid_l)); const int tid = tid_l, lane = tid & 63, w = __builtin_amdgcn_readfirstlane(tid >> 6), i = lane & 15, fq = lane >> 4;
    bf16* Kl = (bf16*)lds; bf16* Ktl = (bf16*)(lds + 18432); bf16* Vtl = (bf16*)(lds + 35840); bf16* Stl = (bf16*)(lds + 53248);
    unsigned char* C = A.ws + WS_C;
    const int T = isctx ? 256 : 2048, nc = T / 128, base = isctx ? b * 256 : MCTX + b * 2048;
    const bf16* RQ = (const bf16*)(C + C_RQ) + h * 64; const bf16* RK = (const bf16*)(C + C_RK) + h * 64; const bf16* RKT = (const bf16*)(C + C_RKT) + (size_t)(h * 64) * M; const bf16* RVT = (const bf16*)(C + C_RVT) + (size_t)(h * 64) * M; const bf16* RG = (const bf16*)(C + C_RG) + h * 64;
    bf16* OB = (bf16*)(A.ws + WS_B) + 1024 + 256 + h * 64;
    const float* gain = A.in[22] + l * 256 + h * 64;
    const int dt0 = (2 * w) >> 2, et0 = (2 * w) & 3, et1 = et0 + 1;
    for (int dir = 0; dir < 2; ++dir) {
        const float xdec = A.in[dir == 0 ? 20 : 21][l * 4 + h];
        const float l2g = -log1pf(__expf(-xdec)) * 1.4426950408889634f;
        f32x4 st[2];
        if (isctx) { st[0] = (f32x4){0.f, 0.f, 0.f, 0.f}; st[1] = st[0]; }
        else {
            const float* s0 = A.in[dir == 0 ? 8 : 9] + ((size_t)(b * 2 + l) * 4 + h) * 4096;
#pragma unroll
            for (int r = 0; r < 4; ++r) { st[0][r] = s0[(16 * dt0 + 4 * fq + r) * 64 + 16 * et0 + i]; st[1][r] = s0[(16 * dt0 + 4 * fq + r) * 64 + 16 * et1 + i]; }
        }
        __syncthreads();
        { u32x2 w0, w1; w0.x = pk2(st[0][0], st[0][1]); w0.y = pk2(st[0][2], st[0][3]); w1.x = pk2(st[1][0], st[1][1]); w1.y = pk2(st[1][2], st[1][3]);
          *(u32x2*)(Stl + (16 * et0 + i) * KS + 16 * dt0 + 4 * fq) = w0; *(u32x2*)(Stl + (16 * et1 + i) * KS + 16 * dt0 + 4 * fq) = w1; }
        const float cdec = __builtin_amdgcn_exp2f(128.f * l2g);
        for (int c = 0; c < nc; ++c) {
            const int ca = (dir == 0) ? c : nc - 1 - c; const int r0 = base + 128 * ca;
#pragma unroll
            for (int rep = 0; rep < 2; ++rep) {
                const int idx = tid + NTHR * rep, tok = idx >> 3, c8 = idx & 7, rowd = idx >> 4, c16 = idx & 15;
                *(u32x4*)(Kl + tok * KS + 8 * c8) = *(const u32x4*)(RK + (size_t)(r0 + tok) * 256 + 8 * c8);
                *(u32x4*)(Ktl + rowd * TS + 8 * c16) = *(const u32x4*)(RKT + (size_t)rowd * M + r0 + 8 * c16);
                *(u32x4*)(Vtl + rowd * TS + 8 * c16) = *(const u32x4*)(RVT + (size_t)rowd * M + r0 + 8 * c16);
            }
            bf16x8 qf[2];
#pragma unroll
            for (int ks = 0; ks < 2; ++ks) qf[ks] = *(const bf16x8*)(RQ + (size_t)(r0 + 16 * w + i) * 256 + 32 * ks + 8 * fq);
            __syncthreads();
            f32x4 oacc[4];
#pragma unroll
            for (int t = 0; t < 4; ++t) oacc[t] = (f32x4){0.f, 0.f, 0.f, 0.f};
            const int ia = 16 * w + i;
#pragma unroll
            for (int k2 = 0; k2 < 4; ++k2) {
                const bool need = (dir == 0) ? (2 * k2 <= w) : (2 * k2 + 1 >= w);
                if (need) {
                    f32x4 s[2];
#pragma unroll
                    for (int j2 = 0; j2 < 2; ++j2) {
                        const int jt = 2 * k2 + j2;
                        s[j2] = (f32x4){0.f, 0.f, 0.f, 0.f};
#pragma unroll
                        for (int ks = 0; ks < 2; ++ks) { const bf16x8 kf = *(const bf16x8*)(Kl + (16 * jt + i) * KS + 32 * ks + 8 * fq); s[j2] = MFMA16(kf, qf[ks], s[j2]); }
#pragma unroll
                        for (int r = 0; r < 4; ++r) {
                            const int ja = 16 * jt + 4 * fq + r; const int df = (dir == 0) ? (ia - ja) : (ja - ia);
                            const bool ok = (dir == 0) ? (df >= 0) : (df > 0);
                            s[j2][r] = ok ? s[j2][r] * __builtin_amdgcn_exp2f(l2g * (float)df) : 0.f;
                        }
                    }
                    u32x4 pw; pw.x = pk2(s[0][0], s[0][1]); pw.y = pk2(s[0][2], s[0][3]); pw.z = pk2(s[1][0], s[1][1]); pw.w = pk2(s[1][2], s[1][3]);
                    const bf16x8 pb = __builtin_bit_cast(bf16x8, pw);
#pragma unroll
                    for (int t = 0; t < 4; ++t) {
                        const bf16* vp = Vtl + (16 * t + i) * TS + 32 * k2 + 4 * fq;
                        const u32x2 va = *(const u32x2*)vp, vb = *(const u32x2*)(vp + 16);
                        u32x4 vw; vw.x = va.x; vw.y = va.y; vw.z = vb.x; vw.w = vb.y;
                        oacc[t] = MFMA16(__builtin_bit_cast(bf16x8, vw), pb, oacc[t]);
                    }
                }
            }
            {
                const float qd = __builtin_amdgcn_exp2f(l2g * (float)((dir == 0) ? (ia + 1) : (128 - ia)));
#pragma unroll
                for (int t = 0; t < 4; ++t) {
                    f32x4 oi = (f32x4){0.f, 0.f, 0.f, 0.f};
#pragma unroll
                    for (int ks = 0; ks < 2; ++ks) { const bf16x8 sf = *(const bf16x8*)(Stl + (16 * t + i) * KS + 32 * ks + 8 * fq); oi = MFMA16(sf, qf[ks], oi); }
                    oacc[t] = oacc[t] + oi * qd;
                }
            }
            {
                bf16* od = OB + (size_t)(r0 + ia) * 2048 + 4 * fq;
                if (dir == 0) {
#pragma unroll
                    for (int t = 0; t < 4; ++t) { u32x2 wv; wv.x = pk2(oacc[t][0], oacc[t][1]); wv.y = pk2(oacc[t][2], oacc[t][3]); *(u32x2*)(od + 16 * t) = wv; }
                } else {
                    float sm = 0.f;
#pragma unroll
                    for (int t = 0; t < 4; ++t) { const u32x2 pf = *(const u32x2*)(od + 16 * t); oacc[t][0] += bflo(pf.x); oacc[t][1] += bfhi(pf.x); oacc[t][2] += bflo(pf.y); oacc[t][3] += bfhi(pf.y);
                        sm += (oacc[t][0] + oacc[t][1]) + (oacc[t][2] + oacc[t][3]); }
                    sm += __shfl_xor(sm, 16); sm += __shfl_xor(sm, 32);
                    const float mu = sm * (1.f / 64.f); float sq = 0.f;
#pragma unroll
                    for (int t = 0; t < 4; ++t) { oacc[t] = oacc[t] - mu; sq += (oacc[t][0] * oacc[t][0] + oacc[t][1] * oacc[t][1]) + (oacc[t][2] * oacc[t][2] + oacc[t][3] * oacc[t][3]); }
                    sq += __shfl_xor(sq, 16); sq += __shfl_xor(sq, 32);
                    const float rstd = 1.f / sqrtf(sq * (1.f / 64.f) + EPS);
                    const bf16* gp = RG + (size_t)(r0 + ia) * 256 + 4 * fq;
#pragma unroll
                    for (int t = 0; t < 4; ++t) { const u32x2 gg = *(const u32x2*)(gp + 16 * t); const f32x4 gn = *(const f32x4*)(gain + 16 * t + 4 * fq);
                        u32x2 wv; wv.x = pk2(bflo(gg.x) * oacc[t][0] * rstd * gn[0], bfhi(gg.x) * oacc[t][1] * rstd * gn[1]); wv.y = pk2(bflo(gg.y) * oacc[t][2] * rstd * gn[2], bfhi(gg.y) * oacc[t][3] * rstd * gn[3]);
                        *(u32x2*)(od + 16 * t) = wv; }
                }
            }
            __syncthreads();
            st[0] = st[0] * cdec; st[1] = st[1] * cdec;
#pragma unroll
            for (int ks = 0; ks < 4; ++ks) {
                const u32x4 kr = *(const u32x4*)(Ktl + (16 * dt0 + i) * TS + 32 * ks + 8 * fq);
                const int j0 = 32 * ks + 8 * fq;
                float dk[8];
#pragma unroll
                for (int e = 0; e < 8; ++e) dk[e] = __builtin_amdgcn_exp2f(l2g * (float)((dir == 0) ? (127 - j0 - e) : (j0 + e)));
                u32x4 kw; kw.x = pk2(bflo(kr.x) * dk[0], bfhi(kr.x) * dk[1]); kw.y = pk2(bflo(kr.y) * dk[2], bfhi(kr.y) * dk[3]); kw.z = pk2(bflo(kr.z) * dk[4], bfhi(kr.z) * dk[5]); kw.w = pk2(bflo(kr.w) * dk[6], bfhi(kr.w) * dk[7]);
                const bf16x8 kf = __builtin_bit_cast(bf16x8, kw);
                st[0] = MFMA16(kf, *(const bf16x8*)(Vtl + (16 * et0 + i) * TS + 32 * ks + 8 * fq), st[0]);
                st[1] = MFMA16(kf, *(const bf16x8*)(Vtl + (16 * et1 + i) * TS + 32 * ks + 8 * fq), st[1]);
            }
#pragma unroll
            for (int j = 0; j < 2; ++j) { u32x2 w0; w0.x = pk2(st[j][0], st[j][1]); w0.y = pk2(st[j][2], st[j][3]); *(u32x2*)(Stl + (16 * (et0 + j) + i) * KS + 16 * dt0 + 4 * fq) = w0; }
            __syncthreads();
        }
        if (isctx) {
            float* so = A.out + (dir == 0 ? O_RF : O_RB) + ((size_t)(b * 2 + l) * 4 + h) * 4096;
#pragma unroll
            for (int r = 0; r < 4; ++r) { so[(16 * dt0 + 4 * fq + r) * 64 + 16 * et0 + i] = st[0][r]; so[(16 * dt0 + 4 * fq + r) * 64 + 16 * et1 + i] = st[1][r]; }
        }
    }
}

constexpr int NU_ATT = 912;
__device__ __forceinline__ void attn_dispatch(KARGS A, unsigned char* lds, int l, int u) {
    unsigned char* C = A.ws + WS_C; unsigned char* cb = A.ws + WS_CACHE + (size_t)l * CACHE_L;
    bf16* OBASE = (bf16*)(A.ws + WS_B) + 1024;
    if (u < 16 || (u >= 400 && u < 528)) { const bool rc = (u >= 400); const int v = rc ? u - 400 : u; for (int rr = 0; rr < ((REPMASK & 0x10000) && !rc ? 2 : 1); ++rr) ret_unit(A, lds, l, rc, v >> 2, v & 3); return; }
    int type, b, h, n; bool isctx;
    if (u < 400) { const int v = (u - 16) & 127; type = (u < 144) ? 0 : (u < 272) ? 2 : 1; b = v >> 5; h = (v >> 3) & 3; n = v & 7; isctx = false; }
    else { const int v = u - 528; type = v >> 7; b = (v & 127) >> 2; h = v & 3; n = 0; isctx = true; }
    const int T = isctx ? 256 : 2048, base = isctx ? b * 256 : MCTX + b * 2048, q0 = base + 256 * n;
    ASeg s0, s1; s1.nt = 0; s1.k1 = nullptr; s1.k2 = nullptr; s1.v = nullptr; s1.k1s = 0; s1.k2s = 0; s1.vs = 0;
    if (type == 0) {
        const bf16* KN = (const bf16*)(C + C_KN) + h * 64; const bf16* MVT = (const bf16*)(C + C_MVT) + (size_t)(h * 64) * MKVP; const bf16* KPE = (const bf16*)(C + C_KPE);
        s0.k1 = KN + (size_t)base * 256; s0.k1s = 256; s0.k2 = KPE + (size_t)base * 32; s0.k2s = 32; s0.v = MVT + base; s0.vs = MKVP; s0.nt = T / 64;
        if (!isctx) { s1.k1 = KN + (size_t)(M + b * 256) * 256; s1.k1s = 256; s1.k2 = (const bf16*)(cb + CA_KPE) + (size_t)(b * 256) * 32; s1.k2s = 32; s1.v = MVT + (M + b * 256); s1.vs = MKVP; s1.nt = 4; }
        attn_unit<96>(lds, (const bf16*)(C + C_QA) + (size_t)q0 * 384 + h * 96, 384, s0, s1, 0, 0, 0, -1e30f, 0.f, OBASE + (size_t)q0 * 2048 + h * 64, 2048);
    } else {
        const int kh = h >> 1; const bool win = (type == 1);
        const bf16* KV = (const bf16*)(C + (win ? C_WKV : C_GKV)) + kh * 64;
        int klo = 0, khi = T;
        if (win && !isctx) { klo = 256 * n - 128; if (klo < 0) klo = 0; khi = 256 * n + 384; if (khi > T) khi = T; }
        s0.k1 = KV + (size_t)(base + klo) * 256; s0.k1s = 256; s0.k2 = nullptr; s0.k2s = 0; s0.v = (const bf16*)(C + (win ? C_WVT : C_GVT)) + (size_t)(kh * 64) * M + base + klo; s0.vs = M; s0.nt = (khi - klo) / 64;
        if (!isctx) { s1.k1 = (const bf16*)(cb + (win ? CA_WK : CA_GK)) + (size_t)(b * 256) * 128 + kh * 64; s1.k1s = 128; s1.v = (const bf16*)(cb + (win ? CA_WV : CA_GV)) + (size_t)(kh * 64) * 1024 + b * 256; s1.vs = 1024; s1.nt = 4; }
        float m0 = -1e30f, l0 = 0.f;
        if (win) { m0 = A.in[23][l * 4 + h] * 1.4426950408889634f; l0 = 1.f; }
        attn_unit<64>(lds, (const bf16*)(C + (win ? C_WQ : C_GQ)) + (size_t)q0 * 256 + h * 64, 256, s0, s1, (win && !isctx) ? 1 : 0, 256 * n, klo, m0, l0, OBASE + (size_t)q0 * 2048 + (win ? 512 : 768) + h * 64, 2048);
    }
}

#define XB_TMO      128
#define XB_XCNT(j)  (256  + 64 * (j))
#define XB_XSUB(j)  (1280 + 64 * (j))
#define XB_XGEN(j)  (2304 + 64 * (j))
#define XB_TOP      3328
#define XB_TOPGEN   3392
#define XCD_BAR_WORDS 3456
#define XB_SPIN_CAP (1u << 18)

__device__ __forceinline__ unsigned xb_ld(unsigned* p)              { return __hip_atomic_load(p, __ATOMIC_RELAXED, __HIP_MEMORY_SCOPE_AGENT); }
__device__ __forceinline__ unsigned xb_add(unsigned* p, unsigned v) { return __hip_atomic_fetch_add(p, v, __ATOMIC_RELAXED, __HIP_MEMORY_SCOPE_AGENT); }
__device__ __forceinline__ unsigned xb_xcc_id() { return (unsigned)__builtin_amdgcn_s_getreg((3 << 11) | 20) & 0xFu; }
#define XB_SPIN(cond, bar) do { unsigned _sp = 0; while (cond) { __builtin_amdgcn_s_sleep(1); \
    if ((++_sp & 255u) == 0u) { if (xb_ld(&(bar)[XB_TMO])) break; if (_sp > XB_SPIN_CAP) { atomicAdd(&(bar)[XB_TMO], 1u); break; } } } } while (0)

struct XcdBarrier {
    unsigned* bar; unsigned x;
    volatile LAS unsigned* st;
};

__device__ __forceinline__ XcdBarrier xcd_barrier_post(unsigned* bar, volatile LAS unsigned* st) {
    XcdBarrier b; b.bar = bar; b.x = xb_xcc_id(); b.st = st;
    if (threadIdx.x == 0) (void)xb_add(&bar[XB_XCNT(b.x)], 1u);
    return b;
}
__device__ __forceinline__ void xcd_barrier_complete(unsigned* bar, unsigned x, unsigned& nloc, unsigned& nx) {
    const unsigned G = gridDim.x * gridDim.y * gridDim.z;
    unsigned sum, cnt, mine, sp = 0u;
    for (;;) {
        sum = 0u; cnt = 0u; mine = 0u;
#pragma unroll
        for (unsigned j = 0; j < 16; ++j) { const unsigned c = xb_ld(&bar[XB_XCNT(j)]); sum += c; cnt += (c > 0u) ? 1u : 0u; mine = (j == x) ? c : mine; }
        if (sum == G) break;
        __builtin_amdgcn_s_sleep(1);
        if ((++sp & 255u) == 0u) { if (xb_ld(&bar[XB_TMO])) break; if (sp > XB_SPIN_CAP) { atomicAdd(&bar[XB_TMO], 1u); break; } }
    }
    nloc = mine > 0u ? mine : 1u; nx = cnt > 0u ? cnt : 1u;
}

__device__ __forceinline__ void xcd_barrier(const XcdBarrier& b) {
    asm volatile("s_waitcnt vmcnt(0)" ::: "memory");
    __syncthreads();
    if (threadIdx.x == 0) {
        unsigned* bar = b.bar; asm volatile("" : "+s"(bar));
        __builtin_amdgcn_s_waitcnt(0);
        unsigned nloc = b.st[0], nx = b.st[1];
        if (nloc == 0u) { xcd_barrier_complete(bar, b.x, nloc, nx); b.st[0] = nloc; b.st[1] = nx; }
        const unsigned old = xb_add(&bar[XB_XSUB(b.x)], 1u);
        const unsigned gen = old / nloc;
        if (old + 1u == (gen + 1u) * nloc) {
            __builtin_amdgcn_fence(__ATOMIC_RELEASE, "agent");
            asm volatile("s_waitcnt vmcnt(0)" ::: "memory");
            const unsigned og = xb_add(&bar[XB_TOP], 1u);
            const unsigned tg = og / nx;
            if (og + 1u == (tg + 1u) * nx) xb_add(&bar[XB_TOPGEN], 1u);
            else XB_SPIN(xb_ld(&bar[XB_TOPGEN]) == tg, bar);
            __builtin_amdgcn_fence(__ATOMIC_ACQUIRE, "agent");
            xb_add(&bar[XB_XGEN(b.x)], 1u);
            asm volatile("s_waitcnt vmcnt(0)" ::: "memory");
        } else {
            XB_SPIN(xb_ld(&bar[XB_XGEN(b.x)]) == gen, bar);
            __builtin_amdgcn_fence(__ATOMIC_ACQUIRE, "agent");
            asm volatile("s_waitcnt vmcnt(0)" ::: "memory");
        }
    }
    __syncthreads();
}

constexpr int NPHASE = 24;
template <int PHM> __global__ void __launch_bounds__(NTHR, 2) fwd_kernel(Args A_unused) {
    extern __shared__ __attribute__((aligned(16))) unsigned char lds[];
    cg::grid_group grid = cg::this_grid();
    PG8_LAS unsigned char* glds = (PG8_LAS unsigned char*)lds;
    const int G = GRID;
#define FRESH_TID() int tid_f = threadIdx.x; asm volatile("" : "+v"(tid_f)); const int tid = tid_f, lane = tid & 63, wave = tid >> 6, gw = blockIdx.x * NWAVES + wave, NGW = G * NWAVES, gt = blockIdx.x * NTHR + tid, NGT = G * NTHR; (void)lane; (void)gw; (void)NGW; (void)gt; (void)NGT
    KARGS A0 = *ka_fresh();
#define PHASE_LOCALS() KARGS A = *ka_fresh(); unsigned char* ws = A.ws; unsigned char* C = ws + WS_C; const float* mod = (const float*)(ws + WS_MOD); (void)C; (void)mod
    unsigned char* ws0 = A0.ws;
    volatile LAS unsigned* bst = (volatile LAS unsigned*)((LAS unsigned char*)lds + (LDS_BYTES - 64));
    if (threadIdx.x < 2) bst[threadIdx.x] = 0u;
    __syncthreads();
    XcdBarrier xbar = xcd_barrier_post((unsigned*)(ws0 + WS_XBAR), bst);
    const int lo = A0.ph_lo, hi = A0.ph_hi;
#define KIND(k) ((k) < 2 ? (k) : 2 + (((k) - 2) % 11))
#define IN(k) (((PHM >> KIND(k)) & 1) && lo <= (k) && (k) < hi)
#ifdef SEAM_CG
#define SEAM(k) do { if (IN(k) && IN((k) + 1)) grid.sync(); } while (0)
#else
#define SEAM(k) do { if (IN(k) && IN((k) + 1)) { if ((k) == 0) grid.sync(); else xcd_barrier(xbar); } } while (0)
#endif
    if (IN(0)) { KARGS A = *ka_fresh(); for (int rep = 0; rep < NREP(0); ++rep) { ph0(A, lds); if (REPMASK) __syncthreads(); } } SEAM(0);
    if (IN(1)) { KARGS A = *ka_fresh(); rowpass<0>(A, 0, true, 0, 0, nullptr); } SEAM(1);
    for (int l = 0; l < 2; ++l) {
        const int P = 2 + 11 * l;
        if (IN(P + 0)) {
            PHASE_LOCALS();
            pg8::Gemm g{(const bf16*)(ws + WS_B), (const bf16*)(ws + WS_WIN), M, NPROJ, 1024, 2048, 1 << 20, 0};
            pg8::StaticOrder S; S.init(M, NPROJ, G, (int)blockIdx.x);
            EpiProj E; E.ws = ws; E.out = A.out; E.l = l; E.lds = lds; E.gq_lat = A.in[15] + l * 256; E.gkv_lat = A.in[17] + l * 128; E.gqn = A.in[24] + l * 64; E.gkn = A.in[25] + l * 64;
            for (int rep = 0; rep < NREP(2); ++rep) { pg8::gemm_phase<EpiProj, pg8::StaticOrder, true, true>(glds, g, S, E); if (rep + 1 < 2 && REPMASK) __syncthreads(); }
            FRESH_TID();
            bf16* ckv = (bf16*)(C + C_CKV) + (size_t)M * 128;
            for (int i = gt; i < 1024 * 128; i += NGT) { const int r = i >> 7, c = i & 127, b = r >> 8, s = r & 255; ckv[i] = (bf16)f2bf(A.in[2][((size_t)(b * 2 + l) * 256 + s) * 128 + c]); }
        }
        SEAM(P + 0);
        if (IN(P + 1)) {
            PHASE_LOCALS();
            { int kq = 256; asm volatile("" : "+s"(kq));
              pg8::Gemm g{(const bf16*)(C + C_QL), (const bf16*)(ws + WS_WUQ), M, 512, kq, 256, 1 << 20, 0}; pg8::StaticOrder S; S.init(M, 512, G, (int)blockIdx.x);
              EpiQa E; E.ws = ws; pg8::gemm_phase<EpiQa, pg8::StaticOrder, true, true>(glds, g, S, E); }
        }
        if (IN(P + 2)) {
            __syncthreads();
            PHASE_LOCALS();
            { int kk = 128; asm volatile("" : "+s"(kk));
              pg8::Gemm g{(const bf16*)(C + C_CKV), (const bf16*)(ws + WS_WUKV), MKVP, 512, kk, 128, 1 << 20, 0}; pg8::StaticOrder S; S.init(MKVP, 512, G, (int)blockIdx.x);
              EpiKv E; E.ws = ws; E.lds = lds; pg8::gemm_phase<EpiKv, pg8::StaticOrder, true, true>(glds, g, S, E); }
            FRESH_TID();
            const float* sskv = (const float*)(ws + WS_SSKV);
            for (int i = gt; i < MCTX * 32; i += NGT) { const int row = i >> 5, c4 = i & 31; const f32x4 s4 = *(const f32x4*)(sskv + row * 4);
                const float rs = 1.f / sqrtf(((s4[0] + s4[1]) + (s4[2] + s4[3])) * (1.f / 128.f) + EPS);
                f32x4* p = (f32x4*)(A.out + O_CKV + ((size_t)((row >> 8) * 2 + l) * 256 + (row & 255)) * 128) + c4; *p = *p * rs; }
        }
        SEAM(P + 2);
        if (IN(P + 3)) {
            PHASE_LOCALS();
            FRESH_TID();
            volatile unsigned* slot = (volatile unsigned*)(lds + LDS_BYTES - 16);
            for (int rep = 0; rep < NREP(5); ++rep) {
            unsigned* ctr = (unsigned*)(ws + WS_CTR) + l + 2 * rep;
            for (;;) {
                __syncthreads();
                if (tid == 0) *slot = atomicAdd(ctr, 1u);
                __syncthreads();
                const unsigned u = (unsigned)__builtin_amdgcn_readfirstlane((int)*slot);
                if (u >= (unsigned)NU_ATT) break;
                if ((REPMASK & 0x20000) && rep == 1 && u < 16) continue;
                attn_dispatch(A, lds, l, (int)u);
            }
            }
        }
        SEAM(P + 3);
        if (IN(P + 4)) {
            PHASE_LOCALS();
            pg8::Gemm g{(const bf16*)(ws + WS_B), (const bf16*)(ws + WS_WIN) + (size_t)NPROJ * 1024, M, NGATE, 1024, 2048, 1 << 20, 0};
            BranchOrder S; S.c = (int)((blockIdx.x & 7) * 32 + (blockIdx.x >> 3));
            EpiAct<0> E; E.O = (bf16*)C; E.ldc = 4096;
            for (int rep = 0; rep < NREP(6); ++rep) { pg8::gemm_phase<EpiAct<0>, BranchOrder, true, true>(glds, g, S, E); if (REPMASK) __syncthreads(); }
            asm volatile("s_waitcnt vmcnt(0)" ::: "memory"); __syncthreads();
        }
        if (IN(P + 5)) {
            PHASE_LOCALS();
            pg8::Gemm g{(const bf16*)(ws + WS_B) + 1024, (const bf16*)(ws + WS_WB), M, 4096, 256, 2048, 4, 512};
            BranchOrder S; S.c = (int)((blockIdx.x & 7) * 32 + (blockIdx.x >> 3));
            EpiMerge E; E.GT = (const bf16*)C; E.MG = (bf16*)C;
            pg8::gemm_phase<EpiMerge, BranchOrder, true, true>(glds, g, S, E);
        }
        SEAM(P + 5);
        if (IN(P + 6)) {
            PHASE_LOCALS();
            pg8::Gemm g{(const bf16*)C, (const bf16*)(ws + WS_WO4), M, 1024, 1024, 4096, 1 << 20, 0};
            pg8::StaticOrder S; S.init(M, 1024, G, (int)blockIdx.x);
            EpiRes E; E.xp = (l == 0) ? A.in[0] : A.out + O_Y; E.xs = (l == 0) ? A.in[1] : A.out + O_Y + (size_t)MCTX * 1024; E.gate = mod + (size_t)l * 5 * 6144 + 2048; E.Z = (float*)(ws + WS_B);
            for (int rep = 0; rep < NREP(8); ++rep) { pg8::gemm_phase<EpiRes, pg8::StaticOrder, true, true>(glds, g, S, E); if (REPMASK) __syncthreads(); }
        }
        SEAM(P + 6);
        if (IN(P + 7)) { PHASE_LOCALS(); rowpass<1>(A, l, true, l, 3072, (const float*)(ws + WS_B)); }
        SEAM(P + 7);
        if (IN(P + 8)) {
            PHASE_LOCALS();
            pg8::Gemm g{(const bf16*)(ws + WS_B), (const bf16*)(ws + WS_WUP), M, FF, 1024, 2048, 1 << 20, 0};
            pg8::StaticOrder S; S.init(M, FF, G, (int)blockIdx.x);
            EpiAct<1> E; E.O = (bf16*)C; E.ldc = 4096;
            for (int rep = 0; rep < NREP(10); ++rep) { pg8::gemm_phase<EpiAct<1>, pg8::StaticOrder, true, true>(glds, g, S, E); if (rep + 1 < 2 && REPMASK) __syncthreads(); }
        }
        SEAM(P + 8);
        if (IN(P + 9)) {
            PHASE_LOCALS();
            pg8::Gemm g{(const bf16*)C, (const bf16*)(ws + WS_WDN), M, 1024, 4096, 4096, 1 << 20, 0};
            pg8::StaticOrder S; S.init(M, 1024, G, (int)blockIdx.x);
            EpiRes E; E.xp = A.out + O_Y; E.xs = A.out + O_Y + (size_t)MCTX * 1024; E.gate = mod + (size_t)l * 5 * 6144 + 5120; E.Z = (float*)(ws + WS_B);
            for (int rep = 0; rep < NREP(11); ++rep) { pg8::gemm_phase<EpiRes, pg8::StaticOrder, true, true>(glds, g, S, E); if (rep + 1 < 2 && REPMASK) __syncthreads(); }
        }
        SEAM(P + 9);
        if (IN(P + 10)) {
            PHASE_LOCALS();
            rowpass<2>(A, l, l == 0, 1, 0, (const float*)(ws + WS_B));
            if (l == 0) { __syncthreads(); FRESH_TID(); conv_weights(A, 1, lds, gw, NGW, wave, lane); }
        }
        if (l == 0) SEAM(P + 10);
    }
#undef IN
#undef SEAM
}

extern "C" void kernel_launch(void* const* d_in, const int* in_sizes, int n_in, void* d_out, int out_size, void* d_ws, size_t ws_size, hipStream_t stream) {
    static int grid = 0;
#ifndef SINGLE_LAUNCH
    static const void* kfn[13] = {(const void*)fwd_kernel<1>, (const void*)fwd_kernel<2>, (const void*)fwd_kernel<4>, (const void*)fwd_kernel<8>, (const void*)fwd_kernel<16>, (const void*)fwd_kernel<32>,
                                  (const void*)fwd_kernel<64>, (const void*)fwd_kernel<128>, (const void*)fwd_kernel<256>, (const void*)fwd_kernel<512>, (const void*)fwd_kernel<1024>, (const void*)fwd_kernel<2048>, (const void*)fwd_kernel<4096>};
#endif
    if (grid == 0) {
        if (n_in != 34 || ws_size < 256 * MiB) { fprintf(stderr, "kernel_launch: unexpected n_in %d / ws_size %zu\n", n_in, ws_size); grid = -1; return; }
        int dev = 0, cus = 0, per_cu = 0;
        hipGetDevice(&dev); hipDeviceGetAttribute(&cus, hipDeviceAttributeMultiprocessorCount, dev);
#ifdef SINGLE_LAUNCH
        if (hipFuncSetAttribute((const void*)fwd_kernel<0x1FFF>, hipFuncAttributeMaxDynamicSharedMemorySize, LDS_BYTES) != hipSuccess) { fprintf(stderr, "kernel_launch: hipFuncSetAttribute failed\n"); grid = -1; return; }
        if (hipOccupancyMaxActiveBlocksPerMultiprocessor(&per_cu, (const void*)fwd_kernel<0x1FFF>, NTHR, LDS_BYTES) != hipSuccess || per_cu < 1) { fprintf(stderr, "kernel_launch: occupancy query gives %d\n", per_cu); per_cu = 1; }
#else
        for (int k = 0; k < 13; ++k) if (hipFuncSetAttribute(kfn[k], hipFuncAttributeMaxDynamicSharedMemorySize, LDS_BYTES) != hipSuccess) { fprintf(stderr, "kernel_launch: hipFuncSetAttribute failed\n"); grid = -1; return; }
        (void)per_cu;
#endif
        (void)hipGetLastError();
        grid = GRID; if (cus != GRID) fprintf(stderr, "kernel_launch: built for %d CUs, device has %d\n", GRID, cus);
    }
    if (grid < 0) return;
    if (hipMemsetAsync((char*)d_ws + WS_CTR, 0, 128 * 1024, stream) != hipSuccess) { fprintf(stderr, "kernel_launch: hipMemsetAsync failed\n"); return; }
    Args a{};
    for (int i = 0; i < 34; ++i) a.in[i] = (const float*)d_in[i];
    a.out = (float*)d_out; a.ws = (unsigned char*)d_ws;
#ifdef SINGLE_LAUNCH
    a.ph_lo = 0; a.ph_hi = NPHASE;
    void* args[] = {&a};
    hipError_t e = hipLaunchCooperativeKernel((const void*)fwd_kernel<0x1FFF>, dim3(grid), dim3(NTHR), args, LDS_BYTES, stream);
    if (e != hipSuccess) fprintf(stderr, "cooperative launch failed: %s (grid %d)\n", hipGetErrorString(e), grid);
#else
    for (int p = 0; p < NPHASE; ++p) {
        a.ph_lo = p; a.ph_hi = p + 1;
        void* args[] = {&a};
        const int kind = p < 2 ? p : 2 + (p - 2) % 11;
        hipError_t e = hipLaunchCooperativeKernel(kfn[kind], dim3(grid), dim3(NTHR), args, LDS_BYTES, stream);
        if (e != hipSuccess) { fprintf(stderr, "launch %d failed: %s\n", p, hipGetErrorString(e)); break; }
    }
#endif
}
```
